# Optimizing an MI355X kernel written in HIP

```python
import jax, jax.numpy as jnp
from jax import lax
import numpy as np

D_MODEL = 1024
BATCH = 8
SEQ = 2048
DEPTH = 4
DEC_BATCH = 128
DEC_SEQ = 4
PAST_LEN = 2048
PAGE_SIZE = 128

N_SSM = (DEPTH + 1) // 2
N_ATT = DEPTH // 2
NORM_EPS = 1e-5
D_FF = 4 * D_MODEL
NEG_INF = -1e30

S5_WIDTH = D_MODEL // 2
S5_GROUP = 16
S5_GROUPS = S5_WIDTH // S5_GROUP
S5_STATE = 64

SSD_INNER = D_MODEL
SSD_HEAD_DIM = 64
SSD_HEADS = SSD_INNER // SSD_HEAD_DIM
SSD_STATE = 128
SSD_GROUPS = 4
SSD_CONV = 4
SSD_CONV_DIM = SSD_INNER + 2 * SSD_GROUPS * SSD_STATE
SSD_CHUNK = 128
MIX_EVEN = S5_WIDTH + SSD_INNER
IN_EVEN = S5_WIDTH + SSD_INNER + SSD_CONV_DIM + SSD_HEADS

N_HEADS = 16
HEAD_DIM = D_MODEL // N_HEADS
N_KV = 2
HEADS_PER_KV = N_HEADS // N_KV
KV_W = N_KV * HEAD_DIM
ROPE_DIM = HEAD_DIM // 4
ROPE_THETA = 500000.0
ATT_SCALE = HEAD_DIM ** -0.5
CMP_LEN = 32
CMP_STRIDE = 16
CMP_HIDDEN = 2 * HEAD_DIM
SEL_LEN = 64
SEL_TOPK = 16
FORCE_BONUS = 1e4
WINDOW = 512
ATT_QBLOCK = 128
SEL_QBLOCK = 64
IN_ODD = N_HEADS * HEAD_DIM + 6 * KV_W + 3 * N_HEADS

kernel_name = 'hybrid_s5_ssd_nsa_decode_step'


def rms_norm(x, g):
    xf = x.astype(jnp.float32)
    y = xf * lax.rsqrt(jnp.mean(xf * xf, -1, keepdims=True) + NORM_EPS)
    return (y * g.astype(jnp.float32)).astype(x.dtype)


def _block(n, pref):
    return pref if n % pref == 0 else n


def masked_softmax(s, mask):
    p = jax.nn.softmax(jnp.where(mask, s, NEG_INF), axis=-1)
    return jnp.where(mask, p, 0.0)


def rope(x, pos):
    half = ROPE_DIM // 2
    inv = ROPE_THETA ** (-jnp.arange(half, dtype=jnp.float32) / half)
    ang = pos.astype(jnp.float32)[:, None] * inv
    cos, sin = jnp.cos(ang)[:, None, :], jnp.sin(ang)[:, None, :]
    xr = x[..., :ROPE_DIM].astype(jnp.float32)
    x1, x2 = xr[..., :half], xr[..., half:]
    rot = jnp.concatenate([x1 * cos - x2 * sin, x2 * cos + x1 * sin], -1)
    return jnp.concatenate([rot.astype(x.dtype), x[..., ROPE_DIM:]], -1)


def _cmul(ar, ai, br, bi):
    return ar * br - ai * bi, ar * bi + ai * br


def _s5_combine(e1, e2):
    a1r, a1i, b1r, b1i = e1
    a2r, a2i, b2r, b2i = e2
    ar, ai = _cmul(a2r, a2i, a1r, a1i)
    br, bi = _cmul(a2r, a2i, b1r, b1i)
    return ar, ai, br + b2r, bi + b2i


def s5_mixer(u, h0, a_re, a_im, log_dt, b_re, b_im, c_re, c_im, d_skip, glu_w, glu_b):
    f32 = jnp.float32
    bt, s, _ = u.shape
    ug = u.astype(f32).reshape(bt, s, S5_GROUPS, S5_GROUP)
    a_re = a_re.astype(f32)
    a_im = a_im.astype(f32)
    dt = jnp.exp(log_dt.astype(f32))[:, None]
    mag = jnp.exp(a_re * dt)
    abar_re, abar_im = mag * jnp.cos(a_im * dt), mag * jnp.sin(a_im * dt)
    den = a_re * a_re + a_im * a_im
    f_re = ((abar_re - 1.0) * a_re + abar_im * a_im) / den
    f_im = (abar_im * a_re - (abar_re - 1.0) * a_im) / den
    bbar_re, bbar_im = _cmul(f_re[..., None], f_im[..., None], b_re.astype(f32), b_im.astype(f32))
    bu_re = jnp.einsum('bsgc,gpc->sbgp', ug, bbar_re)
    bu_im = jnp.einsum('bsgc,gpc->sbgp', ug, bbar_im)
    shape_a = (s, 1, S5_GROUPS, S5_STATE)
    acr, aci, hr, hi = lax.associative_scan(
        _s5_combine,
        (jnp.broadcast_to(abar_re, shape_a), jnp.broadcast_to(abar_im, shape_a), bu_re, bu_im),
        axis=0)
    h0f = h0.astype(f32)
    dr, di = _cmul(acr, aci, h0f[None, ..., 0], h0f[None, ..., 1])
    hr = hr + dr
    hi = hi + di
    y = (jnp.einsum('sbgp,gcp->bsgc', hr, c_re.astype(f32))
         - jnp.einsum('sbgp,gcp->bsgc', hi, c_im.astype(f32)))
    y = y + d_skip.astype(f32).reshape(S5_GROUPS, S5_GROUP) * ug
    zg = jnp.einsum('bsgc,gce->bsge', y, glu_w.astype(f32)) + glu_b.astype(f32)
    out = zg[..., :S5_GROUP] * jax.nn.sigmoid(zg[..., S5_GROUP:])
    h_last = jnp.stack([hr[-1], hi[-1]], -1)
    return out.reshape(bt, s, S5_WIDTH), h_last


def _segsum_exp(a):
    t = a.shape[-1]
    cs = jnp.cumsum(a, -1)
    tril = np.tril(np.ones((t, t), dtype=bool))
    return jnp.exp(jnp.where(tril, cs[..., :, None] - cs[..., None, :], -jnp.inf))


def ssd_mixer(z, xbc, dt_raw, conv_buf, h0, conv_w, conv_b, dt_bias, a_log, d_skip, norm_g):
    f32 = jnp.float32
    bt, s, _ = xbc.shape
    xpad = jnp.concatenate([conv_buf.astype(xbc.dtype), xbc], 1)
    conv = conv_b + sum(xpad[:, k:k + s] * conv_w[k] for k in range(SSD_CONV))
    new_buf = xpad[:, s:]
    xbc_a = jax.nn.silu(conv.astype(f32))
    n_bc = SSD_GROUPS * SSD_STATE
    x = xbc_a[..., :SSD_INNER].reshape(bt, s, SSD_HEADS, SSD_HEAD_DIM)
    bm = xbc_a[..., SSD_INNER:SSD_INNER + n_bc]
    cm = xbc_a[..., SSD_INNER + n_bc:]
    dt = jax.nn.softplus(dt_raw.astype(f32) + dt_bias.astype(f32))
    a = -jnp.exp(a_log.astype(f32))
    q = _block(s, SSD_CHUNK)
    nc = s // q
    r = SSD_HEADS // SSD_GROUPS
    xdt = (x * dt[..., None]).reshape(bt, nc, q, SSD_GROUPS, r, SSD_HEAD_DIM)
    bm = bm.reshape(bt, nc, q, SSD_GROUPS, SSD_STATE)
    cm = cm.reshape(bt, nc, q, SSD_GROUPS, SSD_STATE)
    a_dt = (dt * a).reshape(bt, nc, q, SSD_GROUPS, r).transpose(0, 3, 4, 1, 2)
    a_cs = jnp.cumsum(a_dt, -1)
    lmat = _segsum_exp(a_dt)
    cb = jnp.einsum('bclgn,bcsgn->bcgls', cm, bm)
    y_diag = jnp.einsum('bcgls,bgrcls,bcsgrp->bclgrp', cb, lmat, xdt)
    decay = jnp.exp(a_cs[..., -1:] - a_cs)
    states = jnp.einsum('bclgn,bgrcl,bclgrp->bcgrpn', bm, decay, xdt)
    h0g = h0.astype(f32).reshape(bt, 1, SSD_GROUPS, r, SSD_HEAD_DIM, SSD_STATE)
    states = jnp.concatenate([h0g, states], 1)
    chunk_decay = _segsum_exp(jnp.pad(a_cs[..., -1], [(0, 0)] * 3 + [(1, 0)]))
    states = jnp.einsum('bgrzc,bcgrpn->bzgrpn', chunk_decay, states)
    y_off = jnp.einsum('bclgn,bcgrpn,bgrcl->bclgrp', cm, states[:, :-1], jnp.exp(a_cs))
    y = (y_diag + y_off).reshape(bt, s, SSD_HEADS, SSD_HEAD_DIM) + x * d_skip.astype(f32)[:, None]
    y = y.reshape(bt, s, SSD_INNER) * jax.nn.silu(z.astype(f32))
    y = rms_norm(y, norm_g)
    h_last = states[:, -1].reshape(bt, SSD_HEADS, SSD_HEAD_DIM, SSD_STATE)
    return y, h_last, new_buf


def ssm_block(xn, s5_h0, ssd_h0, conv_buf, w_in, a_re, a_im, log_dt, b_re, b_im, c_re, c_im,
              d5, glu_w, glu_b, conv_w, conv_b, dt_bias, a_log, d_ssd, norm_g, w_out):
    proj = xn @ w_in
    o1 = S5_WIDTH
    o2 = o1 + SSD_INNER
    o3 = o2 + SSD_CONV_DIM
    u, z, xbc, dt_raw = proj[..., :o1], proj[..., o1:o2], proj[..., o2:o3], proj[..., o3:]
    ya, s5_h = s5_mixer(u, s5_h0, a_re, a_im, log_dt, b_re, b_im, c_re, c_im, d5, glu_w, glu_b)
    yb, ssd_h, conv_new = ssd_mixer(z, xbc, dt_raw, conv_buf, ssd_h0, conv_w, conv_b, dt_bias, a_log, d_ssd, norm_g)
    y = jnp.concatenate([ya, yb.astype(ya.dtype)], -1).astype(xn.dtype) @ w_out
    return y, s5_h, ssd_h, conv_new


def compress_blocks(k, w1, w2, pe):
    bt, t = k.shape[:2]
    ratio = CMP_LEN // CMP_STRIDE
    n_chunk = t // CMP_STRIDE
    n_cmp = n_chunk - ratio + 1
    ch = k[:, :n_chunk * CMP_STRIDE].reshape(bt, n_chunk, CMP_STRIDE, N_KV, HEAD_DIM)
    blocks = jnp.concatenate([ch[:, j:j + n_cmp] for j in range(ratio)], axis=2)
    blocks = blocks + pe[:, None, :]
    flat = blocks.transpose(0, 1, 3, 2, 4).reshape(bt, n_cmp, N_KV, CMP_LEN * HEAD_DIM)
    return jax.nn.silu(flat @ w1) @ w2


def nsa_compressed(q, full_cmp, q_off, w1, w2, pe):
    s = q.shape[1]
    kc = compress_blocks(full_cmp[:, :, 0], w1[0], w2[0], pe[0])
    vc = compress_blocks(full_cmp[:, :, 1], w1[1], w2[1], pe[1])
    n_cmp = kc.shape[1]
    q_pos = q_off + np.arange(s)
    ends = np.arange(n_cmp) * CMP_STRIDE + CMP_LEN - 1
    mask = ends[None, :] <= q_pos[:, None]
    sc = jnp.einsum('bsgrd,bngd->bsgrn', q, kc).astype(jnp.float32) * ATT_SCALE
    p = masked_softmax(sc, mask[None, :, None, None, :])
    return jnp.einsum('bsgrn,bngd->bsgrd', p, vc.astype(jnp.float32)), p


def nsa_selected(q, full_sel, p_cmp, q_off):
    bt, s = q.shape[:2]
    t = full_sel.shape[1]
    n_slc = -(-t // SEL_LEN)
    n_cmp = p_cmp.shape[-1]
    ci = np.arange(n_cmp)[:, None]
    sj = np.arange(n_slc)[None, :]
    overlap = ((ci * CMP_STRIDE < (sj + 1) * SEL_LEN)
               & (ci * CMP_STRIDE + CMP_LEN > sj * SEL_LEN)).astype(np.float32)
    imp = jnp.einsum('bsgn,nj->bsgj', p_cmp.sum(3), overlap)
    q_pos = q_off + np.arange(s)
    q_blk = q_pos // SEL_LEN
    jj = np.arange(n_slc)[None, :]
    valid = jj * SEL_LEN <= q_pos[:, None]
    forced = (jj == 0) | (jj == q_blk[:, None]) | (jj == q_blk[:, None] - 1)
    score = jnp.where(valid[None, :, None, :],
                      imp + np.where(forced, FORCE_BONUS, 0.0).astype(np.float32)[None, :, None, :],
                      NEG_INF)
    kk = min(SEL_TOPK, n_slc)
    _, idx = lax.top_k(score, kk)
    kv = jnp.pad(full_sel, ((0, 0), (0, n_slc * SEL_LEN - t), (0, 0), (0, 0), (0, 0)))
    kv = kv.reshape(bt, n_slc, SEL_LEN, 2, N_KV, HEAD_DIM).transpose(0, 4, 1, 2, 3, 5)
    kt, vt = kv[..., 0, :], kv[..., 1, :]
    qb = _block(s, SEL_QBLOCK)
    nb = s // qb
    q_blocks = q.reshape(bt, nb, qb, N_KV, HEADS_PER_KV, HEAD_DIM).swapaxes(0, 1)
    idx_blocks = idx.reshape(bt, nb, qb, N_KV, kk).swapaxes(0, 1)
    pos_blocks = jnp.asarray(q_pos.reshape(nb, qb))
    bi = jnp.arange(bt)[:, None, None, None]
    gi = jnp.arange(N_KV)[None, None, :, None]
    offs = jnp.arange(SEL_LEN)

    def one_block(args):
        qblk, iblk, pblk = args
        kg = kt[bi, gi, iblk]
        vg = vt[bi, gi, iblk]
        kpos = iblk[..., None] * SEL_LEN + offs
        mask = (kpos <= pblk[None, :, None, None, None])[:, :, :, None]
        sc = jnp.einsum('bqgrd,bqgkld->bqgrkl', qblk, kg).astype(jnp.float32) * ATT_SCALE
        shp = sc.shape
        p = masked_softmax(sc.reshape(shp[:4] + (kk * SEL_LEN,)),
                           jnp.broadcast_to(mask, shp).reshape(shp[:4] + (kk * SEL_LEN,))).reshape(shp)
        return jnp.einsum('bqgrkl,bqgkld->bqgrd', p, vg.astype(jnp.float32))

    o = lax.map(one_block, (q_blocks, idx_blocks, pos_blocks))
    return o.swapaxes(0, 1).reshape(bt, s, N_KV, HEADS_PER_KV, HEAD_DIM)


def nsa_window(q, full_win, n_prev):
    bt, s = q.shape[:2]
    qb = _block(s, ATT_QBLOCK)
    nb = s // qb
    band = qb + WINDOW - 1
    kv = jnp.pad(full_win, ((0, 0), (WINDOW - 1, 0), (0, 0), (0, 0), (0, 0)))
    q_blocks = q.reshape(bt, nb, qb, N_KV, HEADS_PER_KV, HEAD_DIM).swapaxes(0, 1)

    def one_block(args):
        blk, qblk = args
        start = blk * qb + n_prev
        kvb = lax.dynamic_slice_in_dim(kv, start, band, axis=1)
        k_idx = start - (WINDOW - 1) + jnp.arange(band)
        q_idx = start + jnp.arange(qb)
        rel = q_idx[:, None] - k_idx[None, :]
        mask = (k_idx[None, :] >= 0) & (rel >= 0) & (rel < WINDOW)
        sc = jnp.einsum('bqgrd,blgd->bqgrl', qblk, kvb[:, :, 0]).astype(jnp.float32) * ATT_SCALE
        p = masked_softmax(sc, mask[None, :, None, None, :])
        return jnp.einsum('bqgrl,blgd->bqgrd', p, kvb[:, :, 1].astype(jnp.float32))

    o = lax.map(one_block, (jnp.arange(nb), q_blocks))
    return o.swapaxes(0, 1).reshape(bt, s, N_KV, HEADS_PER_KV, HEAD_DIM)


def _heads(t, n):
    return t.reshape(t.shape[0], t.shape[1], n, HEAD_DIM)


def nsa_block(xn, q_off, past_cmp, past_sel, win_buf, w_in, cmp_w1, cmp_w2, cmp_pos, w_out):
    bt, s, _ = xn.shape
    q_w = N_HEADS * HEAD_DIM
    cuts = np.cumsum([q_w] + [KV_W] * 6).tolist()
    q, k_cmp, v_cmp, k_sel, v_sel, k_win, v_win, g = jnp.split(xn @ w_in, cuts, axis=-1)
    pos = q_off + jnp.arange(s)
    q = rope(_heads(q, N_HEADS), pos).reshape(bt, s, N_KV, HEADS_PER_KV, HEAD_DIM)
    new_cmp = jnp.stack([rope(_heads(k_cmp, N_KV), pos), _heads(v_cmp, N_KV)], 2)
    new_sel = jnp.stack([rope(_heads(k_sel, N_KV), pos), _heads(v_sel, N_KV)], 2)
    new_win = jnp.stack([rope(_heads(k_win, N_KV), pos), _heads(v_win, N_KV)], 2)
    full_cmp = jnp.concatenate([past_cmp.astype(new_cmp.dtype), new_cmp], 1)
    full_sel = jnp.concatenate([past_sel.astype(new_sel.dtype), new_sel], 1)
    full_win = jnp.concatenate([win_buf.astype(new_win.dtype), new_win], 1)
    o_cmp, p_cmp = nsa_compressed(q, full_cmp, q_off, cmp_w1, cmp_w2, cmp_pos)
    o_sel = nsa_selected(q, full_sel, p_cmp, q_off)
    o_win = nsa_window(q, full_win, win_buf.shape[1])
    gate = jax.nn.sigmoid(g.astype(jnp.float32)).reshape(bt, s, N_KV, HEADS_PER_KV, 3)
    o = gate[..., 0:1] * o_cmp + gate[..., 1:2] * o_sel + gate[..., 2:3] * o_win
    y = o.reshape(bt, s, q_w).astype(xn.dtype) @ w_out
    keep = min(WINDOW, full_win.shape[1])
    return y, new_cmp, new_sel, full_win[:, full_win.shape[1] - keep:]


def sq_relu_mlp(xn, w_up, w_down):
    h = jax.nn.relu(xn @ w_up)
    return (h * h) @ w_down


def setup_inputs(seed: int = 0) -> dict:
    key = jax.random.key(seed)
    ks = iter(jax.random.split(key, 64))
    f32 = jnp.float32
    nrm = lambda shape, std=1.0: jax.random.normal(next(ks), shape, f32) * std
    n_pages = PAST_LEN // PAGE_SIZE
    n_pool = (DEC_BATCH * n_pages * 5) // 4
    wbuf = min(WINDOW, PAST_LEN)
    page_table = jax.random.permutation(next(ks), n_pool)[:DEC_BATCH * n_pages].reshape(DEC_BATCH, n_pages).astype(jnp.int32)
    dt_ssd = jnp.exp(jax.random.uniform(next(ks), (N_SSM, SSD_HEADS), f32, np.log(1e-3), np.log(1e-1)))
    return {
        'x_prompt': nrm((BATCH, SEQ, D_MODEL)),
        'x_sample': nrm((DEC_BATCH, DEC_SEQ, D_MODEL)),
        'state_s5': nrm((N_SSM, DEC_BATCH, S5_GROUPS, S5_STATE, 2), 0.1),
        'state_ssd': nrm((N_SSM, DEC_BATCH, SSD_HEADS, SSD_HEAD_DIM, SSD_STATE), 0.1),
        'state_conv': nrm((N_SSM, DEC_BATCH, SSD_CONV - 1, SSD_CONV_DIM)),
        'cache_cmp_kv': nrm((N_ATT, n_pool, PAGE_SIZE, 2, N_KV, HEAD_DIM)),
        'cache_sel_kv': nrm((N_ATT, n_pool, PAGE_SIZE, 2, N_KV, HEAD_DIM)),
        'state_win_kv': nrm((N_ATT, DEC_BATCH, wbuf, 2, N_KV, HEAD_DIM)),
        'page_table': page_table,
        'norm_mix_even': 1.0 + nrm((N_SSM, D_MODEL), 0.01),
        'w_in_even': nrm((N_SSM, D_MODEL, IN_EVEN), D_MODEL ** -0.5),
        's5_a_re': -0.5 + nrm((N_SSM, S5_GROUPS, S5_STATE), 0.01),
        's5_a_im': jnp.pi * jnp.arange(S5_STATE, dtype=f32) + nrm((N_SSM, S5_GROUPS, S5_STATE), 0.01),
        's5_log_dt': jax.random.uniform(next(ks), (N_SSM, S5_GROUPS), f32, np.log(1e-3), np.log(1e-1)),
        's5_b_re': nrm((N_SSM, S5_GROUPS, S5_STATE, S5_GROUP), (2 * S5_GROUP) ** -0.5),
        's5_b_im': nrm((N_SSM, S5_GROUPS, S5_STATE, S5_GROUP), (2 * S5_GROUP) ** -0.5),
        's5_c_re': nrm((N_SSM, S5_GROUPS, S5_GROUP, S5_STATE), S5_STATE ** -0.5),
        's5_c_im': nrm((N_SSM, S5_GROUPS, S5_GROUP, S5_STATE), S5_STATE ** -0.5),
        's5_d': nrm((N_SSM, S5_WIDTH)),
        's5_glu_w': nrm((N_SSM, S5_GROUPS, S5_GROUP, 2 * S5_GROUP), S5_GROUP ** -0.5),
        's5_glu_b': nrm((N_SSM, S5_GROUPS, 2 * S5_GROUP), 0.01),
        'ssd_conv_w': nrm((N_SSM, SSD_CONV, SSD_CONV_DIM), 0.5),
        'ssd_conv_b': nrm((N_SSM, SSD_CONV_DIM), 0.01),
        'ssd_dt_bias': dt_ssd + jnp.log(-jnp.expm1(-dt_ssd)),
        'ssd_a_log': jnp.log(jax.random.uniform(next(ks), (N_SSM, SSD_HEADS), f32, 1.0, 16.0)),
        'ssd_d': 1.0 + nrm((N_SSM, SSD_HEADS), 0.1),
        'ssd_norm': 1.0 + nrm((N_SSM, SSD_INNER), 0.01),
        'w_out_even': nrm((N_SSM, MIX_EVEN, D_MODEL), MIX_EVEN ** -0.5),
        'norm_mix_odd': 1.0 + nrm((N_ATT, D_MODEL), 0.01),
        'w_in_odd': nrm((N_ATT, D_MODEL, IN_ODD), D_MODEL ** -0.5),
        'cmp_w1': nrm((N_ATT, 2, CMP_LEN * HEAD_DIM, CMP_HIDDEN), (CMP_LEN * HEAD_DIM) ** -0.5),
        'cmp_w2': nrm((N_ATT, 2, CMP_HIDDEN, HEAD_DIM), CMP_HIDDEN ** -0.5),
        'cmp_pos': nrm((N_ATT, 2, CMP_LEN, HEAD_DIM), 0.1),
        'w_out_odd': nrm((N_ATT, N_HEADS * HEAD_DIM, D_MODEL), (N_HEADS * HEAD_DIM) ** -0.5),
        'norm_mlp': 1.0 + nrm((DEPTH, D_MODEL), 0.01),
        'w_up': nrm((DEPTH, D_MODEL, D_FF), D_MODEL ** -0.5),
        'w_down': nrm((DEPTH, D_FF, D_MODEL), D_FF ** -0.5),
        'norm_final': 1.0 + nrm((D_MODEL,), 0.01),
    }


def reference(x_prompt, x_sample, state_s5, state_ssd, state_conv, cache_cmp_kv, cache_sel_kv,
              state_win_kv, page_table, norm_mix_even, w_in_even, s5_a_re, s5_a_im, s5_log_dt,
              s5_b_re, s5_b_im, s5_c_re, s5_c_im, s5_d, s5_glu_w, s5_glu_b, ssd_conv_w, ssd_conv_b,
              ssd_dt_bias, ssd_a_log, ssd_d, ssd_norm, w_out_even, norm_mix_odd, w_in_odd, cmp_w1,
              cmp_w2, cmp_pos, w_out_odd, norm_mlp, w_up, w_down, norm_final):
    bp, bs = x_prompt.shape[0], x_sample.shape[0]
    past_len = page_table.shape[1] * PAGE_SIZE
    dt_ = x_prompt.dtype
    hp, hs = x_prompt, x_sample
    s5_p, s5_s, ssd_p, ssd_s, conv_p, conv_s = [], [], [], [], [], []
    cmp_p, cmp_s, sel_p, sel_s, win_p, win_s = [], [], [], [], [], []
    for layer in range(DEPTH):
        i = layer // 2
        if layer % 2 == 0:
            w = (w_in_even[i], s5_a_re[i], s5_a_im[i], s5_log_dt[i], s5_b_re[i], s5_b_im[i],
                 s5_c_re[i], s5_c_im[i], s5_d[i], s5_glu_w[i], s5_glu_b[i], ssd_conv_w[i],
                 ssd_conv_b[i], ssd_dt_bias[i], ssd_a_log[i], ssd_d[i], ssd_norm[i], w_out_even[i])
            y, a, b, c = ssm_block(rms_norm(hp, norm_mix_even[i]),
                                   jnp.zeros((bp, S5_GROUPS, S5_STATE, 2), dt_),
                                   jnp.zeros((bp, SSD_HEADS, SSD_HEAD_DIM, SSD_STATE), dt_),
                                   jnp.zeros((bp, SSD_CONV - 1, SSD_CONV_DIM), dt_), *w)
            hp = hp + y.astype(hp.dtype)
            s5_p.append(a)
            ssd_p.append(b)
            conv_p.append(c)
            y, a, b, c = ssm_block(rms_norm(hs, norm_mix_even[i]), state_s5[i], state_ssd[i], state_conv[i], *w)
            hs = hs + y.astype(hs.dtype)
            s5_s.append(a)
            ssd_s.append(b)
            conv_s.append(c)
        else:
            w = (w_in_odd[i], cmp_w1[i], cmp_w2[i], cmp_pos[i], w_out_odd[i])
            empty = jnp.zeros((bp, 0, 2, N_KV, HEAD_DIM), dt_)
            y, a, b, c = nsa_block(rms_norm(hp, norm_mix_odd[i]), 0, empty, empty, empty, *w)
            hp = hp + y.astype(hp.dtype)
            cmp_p.append(a)
            sel_p.append(b)
            win_p.append(c)
            past_cmp = cache_cmp_kv[i][page_table].reshape(bs, past_len, 2, N_KV, HEAD_DIM)
            past_sel = cache_sel_kv[i][page_table].reshape(bs, past_len, 2, N_KV, HEAD_DIM)
            y, a, b, c = nsa_block(rms_norm(hs, norm_mix_odd[i]), past_len, past_cmp, past_sel, state_win_kv[i], *w)
            hs = hs + y.astype(hs.dtype)
            cmp_s.append(a)
            sel_s.append(b)
            win_s.append(c)
        hp = hp + sq_relu_mlp(rms_norm(hp, norm_mlp[layer]), w_up[layer], w_down[layer])
        hs = hs + sq_relu_mlp(rms_norm(hs, norm_mlp[layer]), w_up[layer], w_down[layer])
    y_prompt = rms_norm(hp, norm_final)
    y_sample = rms_norm(hs, norm_final)
    return (y_prompt, y_sample, jnp.stack(s5_p), jnp.stack(s5_s), jnp.stack(ssd_p), jnp.stack(ssd_s),
            jnp.stack(conv_p), jnp.stack(conv_s), jnp.stack(cmp_p), jnp.stack(cmp_s),
            jnp.stack(sel_p), jnp.stack(sel_s), jnp.stack(win_p), jnp.stack(win_s))
```

```cpp
#define ONE_LAUNCH 1
#ifdef CPU_EMU
#include "emu.h"
#else
#include <hip/hip_runtime.h>
#endif
#include <cstdio>
#include <cstdint>
#include <cmath>

#ifndef CFG_BATCH
#define CFG_BATCH 8
#define CFG_SEQ 2048
#define CFG_DEPTH 4
#define CFG_DEC_BATCH 128
#define CFG_PAST 2048
#define CFG_DFF 4096
#define CFG_TOPK 16
#define CFG_WINDOW 512
#endif
constexpr int DM = 1024, BATCH = CFG_BATCH, SEQ = CFG_SEQ, DEPTH = CFG_DEPTH, DEC_BATCH = CFG_DEC_BATCH, DEC_SEQ = 4, PAST = CFG_PAST, PAGE = 128;
constexpr int N_SSM = (DEPTH + 1) / 2, N_ATT = DEPTH / 2, DFF = CFG_DFF, TOPK = CFG_TOPK, WINDOW = CFG_WINDOW;
constexpr int MP = BATCH * SEQ, MS = DEC_BATCH * DEC_SEQ, MT = MP + MS;
constexpr int S5W = 512, S5G = 32, S5P = 64;
constexpr int SSDH = 16, SSDP = 64, SSDN = 128, SSDG = 4, CONVD = 2048, CHUNK = 128, NCH = SEQ / CHUNK;
constexpr int IN_EVEN = 3600, IN_EVEN_PAD = 3840, IN_ODD = 1840, IN_ODD_PAD = 2048, MIXE = 1536;
constexpr int NPAGES = PAST / PAGE, NPOOL = DEC_BATCH * NPAGES * 5 / 4, WBUF = (WINDOW < PAST ? WINDOW : PAST);
constexpr int WKEEP_P = (WINDOW < SEQ ? WINDOW : SEQ), WKEEP_S = (WINDOW < WBUF + DEC_SEQ ? WINDOW : WBUF + DEC_SEQ);
constexpr int NCHK_P = SEQ / 16, NCHK_S = PAST / 16, NCMP_P = NCHK_P - 1, NCMP_S = (PAST + DEC_SEQ) / 16 - 1;
static_assert((PAST + DEC_SEQ) / 16 == NCHK_S, "sample compression covers the past rows only");
constexpr int NSLC_P = (SEQ + 63) / 64, NSLC_S = (PAST + DEC_SEQ + 63) / 64;
constexpr int CMPROWS = BATCH * NCHK_P * 2 + DEC_BATCH * NCHK_S * 2, CMPROWS_PAD = (CMPROWS + 255) / 256 * 256;
static_assert(MP % 256 == 0 && MS % 64 == 0 && SEQ % CHUNK == 0 && NSLC_P <= 64 && NSLC_S <= 64 && NCMP_P <= 128 && NCMP_S <= 128, "tiling");
constexpr int NROPE = (SEQ > PAST + DEC_SEQ ? SEQ : PAST + DEC_SEQ);
constexpr float EPS = 1e-5f;
enum { I_XP = 0, I_XS, I_S5ST, I_SSDST, I_CONVST, I_CCMP, I_CSEL, I_WINST, I_PT, I_NME, I_WINE, I_S5ARE, I_S5AIM, I_S5LDT, I_S5BRE, I_S5BIM, I_S5CRE, I_S5CIM,
       I_S5D, I_GLUW, I_GLUB, I_CONVW, I_CONVB, I_DTB, I_ALOG, I_SSDD, I_SSDNORM, I_WOUTE, I_NMO, I_WINO, I_CW1, I_CW2, I_CPOS, I_WOUTO, I_NMLP, I_WUP, I_WDN, I_NFIN, N_IN };
constexpr size_t O_YP = 0, O_YS = O_YP + (size_t)MP * DM, O_S5P = O_YS + (size_t)MS * DM, O_S5S = O_S5P + (size_t)N_SSM * BATCH * 4096, O_SSDP = O_S5S + (size_t)N_SSM * DEC_BATCH * 4096,
    O_SSDS = O_SSDP + (size_t)N_SSM * BATCH * 131072, O_CONVP = O_SSDS + (size_t)N_SSM * DEC_BATCH * 131072, O_CONVS = O_CONVP + (size_t)N_SSM * BATCH * 3 * CONVD,
    O_CMPP = O_CONVS + (size_t)N_SSM * DEC_BATCH * 3 * CONVD, O_CMPS = O_CMPP + (size_t)N_ATT * MP * 256, O_SELP = O_CMPS + (size_t)N_ATT * MS * 256, O_SELS = O_SELP + (size_t)N_ATT * MP * 256,
    O_WINP = O_SELS + (size_t)N_ATT * MS * 256, O_WINS = O_WINP + (size_t)N_ATT * BATCH * WKEEP_P * 256, O_END = O_WINS + (size_t)N_ATT * DEC_BATCH * WKEEP_S * 256;
constexpr size_t al(size_t x) { return (x + 4095) / 4096 * 4096; }
constexpr size_t WS_CTL = 0, CTL_BYTES = 1u << 20, WS_TAB = CTL_BYTES - 4096;
constexpr size_t WS_WINE = WS_CTL + CTL_BYTES, WS_WOUTE = WS_WINE + al((size_t)N_SSM * IN_EVEN_PAD * DM * 2), WS_WINO = WS_WOUTE + al((size_t)N_SSM * DM * MIXE * 2),
    WS_WOUTO = WS_WINO + al((size_t)N_ATT * IN_ODD_PAD * DM * 2), WS_WUP = WS_WOUTO + al((size_t)N_ATT * DM * DM * 2), WS_WDN = WS_WUP + al((size_t)DEPTH * DFF * DM * 2),
    WS_CW1 = WS_WDN + al((size_t)DEPTH * DM * DFF * 2), WS_CBIAS = WS_CW1 + al((size_t)N_ATT * 2 * 256 * 1024 * 2), WS_S5A = WS_CBIAS + al((size_t)N_ATT * 2 * 32 * 128 * 4),
    WS_S5B = WS_S5A + al((size_t)N_SSM * S5G * S5P * 2 * 4), WS_S5C = WS_S5B + al((size_t)N_SSM * S5G * 128 * 16 * 2), WS_X = WS_S5C + al((size_t)N_SSM * S5G * 16 * 128 * 2),
    WS_XN = WS_X + al((size_t)MT * DM * 4), WS_PROJ = WS_XN + al((size_t)MT * DM * 2), WS_H = WS_PROJ + al((size_t)MT * IN_EVEN_PAD * 2), WS_YMIX = WS_H + al((size_t)MT * DFF * 2),
    WS_XBCA = WS_YMIX + al((size_t)MT * MIXE * 2), WS_DTV = WS_XBCA + al((size_t)MT * CONVD * 2), WS_ACS = WS_DTV + al((size_t)MT * 16 * 4), WS_YD = WS_ACS + al((size_t)MT * 16 * 4),
    WS_STL = WS_YD + al((size_t)MT * DM * 4), WS_STIN = WS_STL + al((size_t)BATCH * NCH * SSDH * 8192 * 4), WS_CMPA = WS_STIN + al((size_t)BATCH * NCH * SSDH * 8192 * 2),
    WS_CMPAB = WS_CMPA + al((size_t)2 * CMPROWS_PAD * 1024 * 2), WS_KC = WS_CMPAB + al((size_t)2 * CMPROWS_PAD * 256 * 2), WS_DUMMY = WS_KC + al((size_t)2 * (BATCH + DEC_BATCH) * 128 * 128 * 2), WS_SSQ = WS_DUMMY + al((size_t)MT * DM * 4), WS_CW2T = WS_SSQ + al((size_t)MT * 32 * 4), WS_ROPE = WS_CW2T + al((size_t)N_ATT * 2 * 64 * 128 * 2), WS_END = WS_ROPE + al((size_t)NROPE * 16 * 4);

#ifdef CPU_EMU
#define LAS
#define WAIT_VM(n)
#define WAIT_LGKM(n)
#define S_BARRIER() emu::block_barrier()
#define SCHED_BARRIER()
#define SETPRIO(x)
#define WAVE_SYNC() emu::wave_sync()
#define RFL(x) (x)
#define LDS_BARRIER() emu::block_barrier()
#define GLDS16(g, l) emu_glds16((const void*)(g), (void*)(l))
#define MFMA16(a, b, c) emu_mfma16(a, b, c)
#define MFMA32(a, b, c) emu_mfma32(a, b, c)
#define EXP2F(x) exp2f(x)
#define RCPF(x) (1.0f / (x))
#else
#define LAS __attribute__((address_space(3)))
#define WAIT_VM(n) asm volatile("s_waitcnt vmcnt(" #n ")" ::: "memory")
#define WAIT_LGKM(n) asm volatile("s_waitcnt lgkmcnt(" #n ")" ::: "memory")
#define S_BARRIER() __builtin_amdgcn_s_barrier()
#define SCHED_BARRIER() __builtin_amdgcn_sched_barrier(0)
#define SETPRIO(x) __builtin_amdgcn_s_setprio(x)
#define WAVE_SYNC() do { asm volatile("s_waitcnt lgkmcnt(0)" ::: "memory"); __builtin_amdgcn_wave_barrier(); } while (0)
#define RFL(x) __builtin_amdgcn_readfirstlane(x)
#define LDS_BARRIER() do { asm volatile("s_waitcnt lgkmcnt(0)" ::: "memory"); __builtin_amdgcn_s_barrier(); asm volatile("" ::: "memory"); } while (0)
#define GLDS16(g, l) __builtin_amdgcn_global_load_lds((const unsigned*)(g), (LAS unsigned*)(l), 16, 0, 0)
#define MFMA16(a, b, c) __builtin_amdgcn_mfma_f32_16x16x32_bf16(a, b, c, 0, 0, 0)
#define MFMA32(a, b, c) __builtin_amdgcn_mfma_f32_32x32x16_bf16(a, b, c, 0, 0, 0)
#define EXP2F(x) __builtin_amdgcn_exp2f(x)
#define RCPF(x) __builtin_amdgcn_rcpf(x)
#endif

typedef unsigned short bf16_t;
typedef short bf16x8 __attribute__((ext_vector_type(8)));
typedef float f32x4 __attribute__((ext_vector_type(4)));
typedef float f32x16 __attribute__((ext_vector_type(16)));
typedef unsigned u32x4 __attribute__((ext_vector_type(4)));
typedef unsigned u32x2 __attribute__((ext_vector_type(2)));
typedef float f32x2 __attribute__((ext_vector_type(2)));
constexpr int NT = 512, NWAVE = 8;
constexpr int LDS_BYTES = 147456, LDS_MISC = LDS_BYTES - 256;

__device__ __forceinline__ unsigned f2bf(float f) { unsigned u = __builtin_bit_cast(unsigned, f); return (u + 0x7fffu + ((u >> 16) & 1u)) >> 16; }
#ifdef CPU_EMU
__device__ __forceinline__ unsigned pk2(float lo, float hi) { return f2bf(lo) | (f2bf(hi) << 16); }
#else
typedef __bf16 bf16x2_hw __attribute__((ext_vector_type(2)));
__device__ __forceinline__ unsigned pk2(float lo, float hi) { const f32x2 v = {lo, hi}; return __builtin_bit_cast(unsigned, __builtin_convertvector(v, bf16x2_hw)); }
#endif
#ifndef CPU_EMU
__device__ __forceinline__ unsigned f2bf_hw(float f) { return pk2(f, 0.f) & 0xffffu; }
template <int CTRL> __device__ __forceinline__ float dpp_mov(float v) { return __builtin_bit_cast(float, __builtin_amdgcn_update_dpp(0, __builtin_bit_cast(int, v), CTRL, 0xf, 0xf, true)); }
__device__ __forceinline__ float sum8(float v) { v += dpp_mov<0xB1>(v); v += dpp_mov<0x4E>(v); v += dpp_mov<0x141>(v); return v; }
#else
__device__ __forceinline__ unsigned f2bf_hw(float f) { return f2bf(f); }
__device__ __forceinline__ float sum8(float v) { v += __shfl_xor(v, 1); v += __shfl_xor(v, 2); v += __shfl_xor(v, 4); return v; }
#endif
__device__ __forceinline__ float bf2f(unsigned h) { return __builtin_bit_cast(float, (h & 0xffffu) << 16); }
__device__ __forceinline__ float bflo(unsigned w) { return __builtin_bit_cast(float, w << 16); }
__device__ __forceinline__ float bfhi(unsigned w) { return __builtin_bit_cast(float, w & 0xffff0000u); }
__device__ __forceinline__ float wave_sum(float v) {
#pragma unroll
    for (int o = 1; o < 64; o <<= 1) v += __shfl_xor(v, o);
    return v;
}
__device__ __forceinline__ float sigmoidf_(float x) { return 1.f / (1.f + __expf(-x)); }
__device__ __forceinline__ float siluf_(float x) { return x / (1.f + __expf(-x)); }
__device__ __forceinline__ float softplusf_(float x) { return x > 20.f ? x : log1pf(__expf(x)); }

#ifdef CPU_EMU
#define NOINLINE
__device__ __forceinline__ unsigned char* lds_ptr() { return (unsigned char*)emu::W->lds; }
#else
#define NOINLINE __forceinline__
__device__ __forceinline__ unsigned char* lds_ptr() { extern __shared__ __attribute__((aligned(16))) unsigned char lds_dyn[]; return lds_dyn; }
#endif
#ifdef CPU_EMU
#define OPAQUE_V(x)
#define OPAQUE_S(x)
#else
#define OPAQUE_V(x) asm volatile("" : "+v"(x))
#define OPAQUE_S(x) asm volatile("" : "+s"(x))
#endif
struct Args { const float* in[N_IN]; float* out; unsigned char* ws; int ph_lo, ph_hi, dup, pad; };
namespace pg8 {
constexpr int BM = 256, BK = 64, HALF = 128, HTB = HALF * BK * 2, STAGE_BYTES = 8 * HTB, NXCD = 8, WGM = 8;
__host__ __device__ __forceinline__ int lds_byte(int r, int c) { const int st = (r >> 4) * 2 + (c >> 5), rr = r & 15, cc = c & 31, ob = rr * 64 + cc * 2; return st * 1024 + (ob ^ (((ob >> 9) & 1) << 5)); }
__host__ __device__ __forceinline__ void stage_rc(int b, int& R, int& C) { const int st = b / 1024, sb = b % 1024, swz = sb ^ (((sb >> 9) & 1) << 5); R = (st >> 1) * 16 + swz / 64; C = (st & 1) * 32 + (swz % 64) / 2; }
__host__ __device__ __forceinline__ int perm32(int rho) { const int n = rho >> 4, i = rho & 15; return 8 * (i >> 2) + 4 * n + (i & 3); }
struct Unit { int pm, pn; };
struct Gemm { const bf16_t* A; const bf16_t* Bt; int M, N, K; };
struct StaticOrder {
    int nM, nN, nwg, G, c;
    __host__ __device__ void init(int M, int N, int G_, int c_) { nM = M / BM; nN = N / BM; nwg = nM * nN; G = G_; c = c_; }
    __host__ __device__ bool next(int i, Unit& u) const {
        const long L = (long)i * G + c; if (L >= nwg) return false;
        int wgid = (int)L; { const int q = nwg / NXCD, r = nwg % NXCD, xcd = wgid % NXCD, off = wgid / NXCD; wgid = (xcd < r ? xcd * (q + 1) : r * (q + 1) + (xcd - r) * q) + off; }
        const int nig = WGM * nN, gid = wgid / nig, fm = gid * WGM, gsz = (nM - fm) < WGM ? (nM - fm) : WGM;
        u.pm = fm + ((wgid % nig) % gsz); u.pn = (wgid % nig) / gsz; return true;
    }
};
template <int ACT  > struct EpiBf16 {
    static constexpr bool AFTER_DRAIN = false;
    bf16_t* O; int ldc; const float* ssq; const float* rstd_lds;
    __device__ __forceinline__ void operator()(const f32x4 (&acc)[2][2][4][2], const Unit& u, int ui, int wr, int wc, int fr, int fq) const {
        const int row0 = u.pm * BM + wr * 64 + fr, col0 = u.pn * BM + wc * 32 + 8 * fq;
#pragma unroll
        for (int ai = 0; ai < 2; ++ai)
#pragma unroll
            for (int m = 0; m < 4; ++m) { const int row = row0 + ai * HALF + m * 16; bf16_t* rowp = O + (size_t)row * ldc + col0; const float rs = ssq ? rstd_lds[ui * 256 + (row - u.pm * BM)] : 1.f;
#pragma unroll
                for (int bj = 0; bj < 2; ++bj) { f32x4 v0 = acc[ai][bj][m][0] * rs, v1 = acc[ai][bj][m][1] * rs;
                    if (ACT == 1) {
#pragma unroll
                        for (int e = 0; e < 4; ++e) { float a = v0[e] > 0.f ? v0[e] : 0.f, b = v1[e] > 0.f ? v1[e] : 0.f; v0[e] = a * a; v1[e] = b * b; } }
                    u32x4 w; w.x = pk2(v0[0], v0[1]); w.y = pk2(v0[2], v0[3]); w.z = pk2(v1[0], v1[1]); w.w = pk2(v1[2], v1[3]);
                    *(u32x4*)(rowp + bj * HALF) = w; }
            }
    }
};
struct EpiResid {
    static constexpr bool AFTER_DRAIN = false;
    float* X; int ldc; bf16_t* XB; float* ssq;
    __device__ __forceinline__ void operator()(const f32x4 (&acc)[2][2][4][2], const Unit& u, int ui, int wr, int wc, int fr, int fq) const {
        const int row0 = u.pm * BM + wr * 64 + fr, col0 = u.pn * BM + wc * 32 + 8 * fq;
#pragma unroll
        for (int ai = 0; ai < 2; ++ai) { f32x4 xo[4][2][2];
#pragma unroll
            for (int m = 0; m < 4; ++m)
#pragma unroll
                for (int bj = 0; bj < 2; ++bj) { const f32x4* p = (const f32x4*)(X + (size_t)(row0 + ai * HALF + m * 16) * ldc + col0 + bj * HALF); xo[m][bj][0] = p[0]; xo[m][bj][1] = p[1]; }
#ifndef CPU_EMU
            asm volatile("" ::: "memory");
#endif
#pragma unroll
            for (int m = 0; m < 4; ++m) { const int row = row0 + ai * HALF + m * 16; float ss = 0.f;
#pragma unroll
                for (int bj = 0; bj < 2; ++bj) { f32x4* p = (f32x4*)(X + (size_t)row * ldc + col0 + bj * HALF); const f32x4 a = xo[m][bj][0] + acc[ai][bj][m][0], b = xo[m][bj][1] + acc[ai][bj][m][1]; p[0] = a; p[1] = b;
                    ss += (a.x * a.x + a.y * a.y) + (a.z * a.z + a.w * a.w) + (b.x * b.x + b.y * b.y) + (b.z * b.z + b.w * b.w);
                    if (XB) { u32x4 w; w.x = pk2(a.x, a.y); w.y = pk2(a.z, a.w); w.z = pk2(b.x, b.y); w.w = pk2(b.z, b.w); *(u32x4*)(XB + (size_t)row * ldc + col0 + bj * HALF) = w; } }
                ss += __shfl_xor(ss, 16); ss += __shfl_xor(ss, 32);
                if (ssq && fq == 0) ssq[(size_t)row * 32 + 4 * u.pn + wc] = ss; }
#ifndef CPU_EMU
            asm volatile("" ::: "memory");
#endif
        }
    }
};
constexpr f32x16 Z16c = {0.f, 0.f, 0.f, 0.f, 0.f, 0.f, 0.f, 0.f, 0.f, 0.f, 0.f, 0.f, 0.f, 0.f, 0.f, 0.f};
struct EpiCmp {
    static constexpr bool AFTER_DRAIN = true; static constexpr int TP = 264, RPS = 2 * NCHK_P;
    bf16_t* KC; const bf16_t* W2T; const float* cbp; int kv;
    __device__ __forceinline__ void fused(const f32x4 (&acc)[2][2][4][2], const Unit& u, unsigned char* ldsb, int wid, int lane, int wr, int wc, int fr, int fq) const {
        static_assert(NCHK_P == NCHK_S && 256 % RPS == 0, "compression tile = whole sequences");
        bf16_t* T = (bf16_t*)ldsb; float* CB = (float*)(ldsb + 256 * TP * 2); const int tid = wid * 64 + lane;
#pragma unroll
        for (int ai = 0; ai < 2; ++ai)
#pragma unroll
            for (int m = 0; m < 4; ++m) { const int row = ai * HALF + wr * 64 + m * 16 + fr;
#pragma unroll
                for (int bj = 0; bj < 2; ++bj)
#pragma unroll
                    for (int n = 0; n < 2; ++n) { const f32x4 v = acc[ai][bj][m][n]; u32x2 w; w.x = pk2(v.x, v.y); w.y = pk2(v.z, v.w); *(u32x2*)(T + row * TP + bj * HALF + wc * 32 + 8 * fq + 4 * n) = w; } }
        if (tid < 128) { float sb = 0.f; for (int q = 0; q < 32; ++q) sb += cbp[q * 128 + tid]; CB[tid] = sb; }
        LDS_BARRIER();
        for (int it = tid; it < 256 * 16; it += NT) { const int R = it >> 4, c8 = it & 15, i = (R % RPS) >> 1;
            if (i < NCHK_P - 1) { const u32x4 a = *(const u32x4*)(T + R * TP + 8 * c8), bb = *(const u32x4*)(T + (R + 2) * TP + 128 + 8 * c8); const float* cb = CB + 8 * c8; u32x4 pk;
                pk.x = pk2(siluf_(bflo(a.x) + bflo(bb.x) + cb[0]), siluf_(bfhi(a.x) + bfhi(bb.x) + cb[1])); pk.y = pk2(siluf_(bflo(a.y) + bflo(bb.y) + cb[2]), siluf_(bfhi(a.y) + bfhi(bb.y) + cb[3]));
                pk.z = pk2(siluf_(bflo(a.z) + bflo(bb.z) + cb[4]), siluf_(bfhi(a.z) + bfhi(bb.z) + cb[5])); pk.w = pk2(siluf_(bflo(a.w) + bflo(bb.w) + cb[6]), siluf_(bfhi(a.w) + bfhi(bb.w) + cb[7]));
                *(u32x4*)(T + R * TP + 8 * c8) = pk; } }
        LDS_BARRIER();
        { const int r = lane & 31, hi = lane >> 5; f32x16 o0 = Z16c, o1 = Z16c; const bf16_t* ap = T + (32 * wid + r) * TP + 8 * hi; const bf16_t* b0 = W2T + (size_t)r * 128 + 8 * hi; const bf16_t* b1 = b0 + 32 * 128;
#pragma unroll
            for (int k = 0; k < 128; k += 16) { const bf16x8 a = *(const bf16x8*)(ap + k); o0 = MFMA32(a, *(const bf16x8*)(b0 + k), o0); o1 = MFMA32(a, *(const bf16x8*)(b1 + k), o1); }
#pragma unroll
            for (int q = 0; q < 16; ++q) { const int R = 32 * wid + (q & 3) + 8 * (q >> 2) + 4 * hi, i = (R % RPS) >> 1, g = R & 1, seqa = u.pm * (256 / RPS) + R / RPS;
                if (i < NCHK_P - 1 && seqa < BATCH + DEC_BATCH) { bf16_t* dst = KC + (((size_t)kv * (BATCH + DEC_BATCH) + seqa) * 128 + i) * 128 + g * 64 + r; dst[0] = (bf16_t)f2bf(o0[q]); dst[32] = (bf16_t)f2bf(o1[q]); } } }
        LDS_BARRIER();
    }
};
__device__ __forceinline__ void epi_prepass(EpiCmp&, const StaticOrder&) {}
template <class Epi, bool ALIGN_EPI>
__device__ __forceinline__ void gemm_phase(LAS unsigned char* lds, const Gemm g, const StaticOrder& S, const Epi& E) {
    int tid_ = threadIdx.x;
#ifndef CPU_EMU
    asm volatile("" : "+v"(tid_));
#endif
    const int tid = tid_, wid = RFL(tid >> 6), lane = tid & 63, wr = wid >> 2, wc = wid & 3, fr = lane & 15, fq = lane >> 4;
    const int K = g.K, nt = K / BK;
    unsigned voffA[2], voffB[2];
#pragma unroll
    for (int i = 0; i < 2; ++i) { int R, C; stage_rc(tid * 16 + i * 8192, R, C); const int Rb = (R & ~31) + perm32(R & 31);
        voffA[i] = (unsigned)(R * K + C) * 2u; voffB[i] = (unsigned)(Rb * K + C) * 2u; }
    const size_t kstep = (size_t)(BK * 2), hstep = (size_t)HALF * K * 2, tstep = 2 * hstep;
    const unsigned ldsw = (unsigned)wid * 1024u;
    const int aoff = lds_byte(wr * 64 + fr, fq * 8), boff = lds_byte(wc * 32 + fr, fq * 8);
#define PG8_SA(b, h) (((b) * 2 + (h)) * HTB)
#define PG8_SB(b, h) ((4 + (b) * 2 + (h)) * HTB)
#define PG8_STAGE(bufoff, gbase, voff) do { _Pragma("unroll") for (int _i = 0; _i < 2; ++_i) GLDS16((const char*)(gbase) + (voff)[_i], lds + (bufoff) + ldsw + _i * 8192); } while (0)
#define PG8_LDA(dst, b, h) do { _Pragma("unroll") for (int m = 0; m < 4; ++m) _Pragma("unroll") for (int k = 0; k < 2; ++k) dst[m][k] = *(const LAS bf16x8*)(lds + PG8_SA(b, h) + aoff + m * 2048 + k * 1024); } while (0)
#define PG8_LDB(dst, b, h) do { _Pragma("unroll") for (int n = 0; n < 2; ++n) _Pragma("unroll") for (int k = 0; k < 2; ++k) dst[n][k] = *(const LAS bf16x8*)(lds + PG8_SB(b, h) + boff + n * 2048 + k * 1024); } while (0)
#define PG8_MMA(ai, bj, At, Bt) do { SETPRIO(1); _Pragma("unroll") for (int m = 0; m < 4; ++m) _Pragma("unroll") for (int n = 0; n < 2; ++n) _Pragma("unroll") for (int k = 0; k < 2; ++k) \
        acc[ai][bj][m][n] = MFMA16(Bt[n][k], At[m][k], acc[ai][bj][m][n]); SETPRIO(0); } while (0)
    Unit cur, nxt; int ui = 0;
    if (!S.next(0, cur)) return;
    f32x4 acc[2][2][4][2];
#pragma unroll
    for (int a = 0; a < 2; ++a)
#pragma unroll
        for (int b = 0; b < 2; ++b)
#pragma unroll
            for (int m = 0; m < 4; ++m)
#pragma unroll
                for (int n = 0; n < 2; ++n) acc[a][b][m][n] = (f32x4){0.f, 0.f, 0.f, 0.f};
    bf16x8 At[4][2], B0[2][2], B1[2][2];
    const char* cA = (const char*)g.A + (size_t)cur.pm * tstep; const char* cB = (const char*)g.Bt + (size_t)cur.pn * tstep;
    PG8_STAGE(PG8_SB(0, 0), cB, voffB); PG8_STAGE(PG8_SB(0, 1), cB + hstep, voffB); PG8_STAGE(PG8_SA(0, 0), cA, voffA); PG8_STAGE(PG8_SA(0, 1), cA + hstep, voffA);
    if (wr == 1) S_BARRIER();
    WAIT_VM(2); S_BARRIER();
    PG8_STAGE(PG8_SB(1, 0), cB + kstep, voffB); PG8_STAGE(PG8_SA(1, 0), cA + kstep, voffA); PG8_STAGE(PG8_SB(1, 1), cB + hstep + kstep, voffB);
    WAIT_VM(6); S_BARRIER();
    for (;;) {
        const bool has_next = S.next(ui + 1, nxt);
        const char* nA = has_next ? (const char*)g.A + (size_t)nxt.pm * tstep : cA; const char* nB = has_next ? (const char*)g.Bt + (size_t)nxt.pn * tstep : cB;
        for (int t = 0; t < nt; t += 2) {
            const bool last = (t == nt - 2);
            const char* a1 = cA + (size_t)(t + 1) * kstep;
            const char* a2 = last ? nA : cA + (size_t)(t + 2) * kstep; const char* b2 = last ? nB : cB + (size_t)(t + 2) * kstep;
            const char* a3 = a2 + kstep; const char* b3 = b2 + kstep;
            PG8_LDB(B0, 0, 0); PG8_LDB(B1, 0, 1); SCHED_BARRIER(); PG8_LDA(At, 0, 0); PG8_STAGE(PG8_SA(1, 1), a1 + hstep, voffA);
            WAIT_VM(8); WAIT_LGKM(0); S_BARRIER(); PG8_MMA(0, 0, At, B0); PG8_MMA(0, 1, At, B1); S_BARRIER(); SCHED_BARRIER();
            PG8_LDA(At, 0, 1); PG8_STAGE(PG8_SB(0, 0), b2, voffB); PG8_STAGE(PG8_SB(0, 1), b2 + hstep, voffB); PG8_STAGE(PG8_SA(0, 0), a2, voffA);
            WAIT_VM(8); WAIT_LGKM(0); S_BARRIER(); PG8_MMA(1, 0, At, B0); PG8_MMA(1, 1, At, B1); S_BARRIER(); SCHED_BARRIER();
            PG8_LDB(B0, 1, 0); PG8_LDB(B1, 1, 1); SCHED_BARRIER(); PG8_LDA(At, 1, 0); PG8_STAGE(PG8_SA(0, 1), a2 + hstep, voffA);
            WAIT_VM(8); WAIT_LGKM(0); S_BARRIER(); PG8_MMA(0, 0, At, B0); PG8_MMA(0, 1, At, B1); S_BARRIER(); SCHED_BARRIER();
            PG8_LDA(At, 1, 1); PG8_STAGE(PG8_SB(1, 0), b3, voffB); PG8_STAGE(PG8_SB(1, 1), b3 + hstep, voffB); PG8_STAGE(PG8_SA(1, 0), a3, voffA);
            WAIT_VM(8); WAIT_LGKM(0); S_BARRIER(); PG8_MMA(1, 0, At, B0); PG8_MMA(1, 1, At, B1); S_BARRIER(); SCHED_BARRIER();
        }
        if (ALIGN_EPI) { if (wr == 0) S_BARRIER(); }
        if constexpr (!Epi::AFTER_DRAIN) E(acc, cur, ui, wr, wc, fr, fq);
        if (!has_next) break;
#pragma unroll
        for (int a = 0; a < 2; ++a)
#pragma unroll
            for (int b = 0; b < 2; ++b)
#pragma unroll
                for (int m = 0; m < 4; ++m)
#pragma unroll
                    for (int n = 0; n < 2; ++n) acc[a][b][m][n] = (f32x4){0.f, 0.f, 0.f, 0.f};
        cur = nxt; cA = nA; cB = nB; ++ui;
        if (ALIGN_EPI) { if (wr == 1) S_BARRIER(); }
    }
    WAIT_VM(0);
    if (!ALIGN_EPI) { if (wr == 0) S_BARRIER(); }
    S_BARRIER();
    if constexpr (Epi::AFTER_DRAIN) E.fused(acc, cur, (unsigned char*)lds, wid, lane, wr, wc, fr, fq);
#undef PG8_SA
#undef PG8_SB
#undef PG8_STAGE
#undef PG8_LDA
#undef PG8_LDB
#undef PG8_MMA
}
template <int ACT> __device__ __forceinline__ void epi_prepass(EpiBf16<ACT>& E, const StaticOrder& S) {
    float* tab = (float*)(lds_ptr() + STAGE_BYTES); E.rstd_lds = tab;
    if (E.ssq) { Unit u; const int t = threadIdx.x;
        for (int i = 0; i < 15 && S.next(i, u); ++i) if (t < 256) { const f32x4* q = (const f32x4*)(E.ssq + (size_t)(u.pm * BM + t) * 32); float tt = 0.f;
#pragma unroll
            for (int j = 0; j < 8; ++j) { const f32x4 a = q[j]; tt += (a.x + a.y) + (a.z + a.w); }
            tab[i * 256 + t] = 1.f / sqrtf(tt * (1.f / 1024.f) + 1e-5f); }
        __syncthreads(); }
}
__device__ __forceinline__ void epi_prepass(EpiResid&, const StaticOrder&) {}
template <class Epi> __device__ NOINLINE void gemm_call(const bf16_t* A, const bf16_t* Bt, int M, int N, int K, Epi E, int G, int bid) {
    OPAQUE_S(G); OPAQUE_S(bid);
    Gemm g{A, Bt, M, N, K}; StaticOrder S; S.init(M, N, G, bid);
    epi_prepass(E, S);
    gemm_phase<Epi, true>((LAS unsigned char*)lds_ptr(), g, S, E);
}
}
struct Frame {
    unsigned char* lds; int tid, lane, wave, G, bid, gw, NGW;
    const float* const* in; float* out; unsigned char* ws;
};
#define WSP(T, off) ((T*)(F.ws + (off)))
#ifdef CPU_EMU
#define UNIT_BEGIN(F)
#else
#define UNIT_BEGIN(F) do { int z_ = 0; asm volatile("s_mov_b32 %0, 0" : "=s"(z_)); F.ws += z_; F.out += z_; F.lds += z_; int t_ = F.tid; OPAQUE_V(t_); F.tid = t_; F.lane = t_ & 63; F.wave = RFL(t_ >> 6); } while (0)
#endif
__device__ __forceinline__ void frame_refresh(Frame& F) {
    int t = threadIdx.x; OPAQUE_V(t); F.tid = t; F.lane = t & 63; F.wave = RFL(t >> 6); { int b_ = blockIdx.x, g_ = gridDim.x; OPAQUE_S(b_); OPAQUE_S(g_); F.bid = b_; F.G = g_; } F.NGW = F.G * NWAVE; F.gw = F.bid * NWAVE + F.wave; F.lds = lds_ptr();
}
__device__ __forceinline__ void tr_job(Frame& F, int& base, const float* src, int ldsrc, int nvalid, int npad, int K, bf16_t* dst, int rowoff, const float* gk = nullptr) {
    float* scr = (float*)(F.lds + F.wave * 16640);
    const int nblk = npad / 64, nitems = (K / 64) * nblk, lane = F.lane, rr = lane >> 4, c4 = lane & 15;
    int it = base + (((F.gw - base) % F.NGW) + F.NGW) % F.NGW;
    for (; it < base + nitems; it += F.NGW) {
        const int item = it - base, kb = item / nblk, nb = item % nblk, k0 = 64 * kb, n0 = 64 * nb; const bool ok = n0 + 4 * c4 < nvalid;
        f32x4 v[16];
#pragma unroll
        for (int i = 0; i < 16; ++i) v[i] = ok ? *(const f32x4*)(src + (size_t)(k0 + 4 * i + rr) * ldsrc + n0 + 4 * c4) : (f32x4){0.f, 0.f, 0.f, 0.f};
#pragma unroll
        for (int i = 0; i < 16; ++i) { const float g = gk ? gk[k0 + 4 * i + rr] : 1.f; float* p = scr + (4 * i + rr) * 65 + 4 * c4; p[0] = v[i].x * g; p[1] = v[i].y * g; p[2] = v[i].z * g; p[3] = v[i].w * g; }
        WAVE_SYNC();
        const int c = lane & 7;
#pragma unroll
        for (int j = 0; j < 8; ++j) { const int n = (lane >> 3) + 8 * j; const float* q = scr + (8 * c) * 65 + n;
            u32x4 o; o.x = pk2(q[0 * 65], q[1 * 65]); o.y = pk2(q[2 * 65], q[3 * 65]); o.z = pk2(q[4 * 65], q[5 * 65]); o.w = pk2(q[6 * 65], q[7 * 65]);
            *(u32x4*)(dst + (size_t)(rowoff + n0 + n) * K + k0 + 8 * c) = o; }
        WAVE_SYNC();
    }
    base += nitems;
}
__device__ __forceinline__ void norm_row(Frame& F, const float* xrow, const float* g, bf16_t* obf, float* of32, float* xcopy) {
    const f32x4* xr = (const f32x4*)xrow + F.lane; f32x4 v[4]; float s = 0.f;
#pragma unroll
    for (int j = 0; j < 4; ++j) { v[j] = xr[64 * j]; s += (v[j].x * v[j].x + v[j].y * v[j].y) + (v[j].z * v[j].z + v[j].w * v[j].w); }
    const float r = 1.f / sqrtf(wave_sum(s) * (1.f / DM) + EPS);
#pragma unroll
    for (int j = 0; j < 4; ++j) { const f32x4 gg = ((const f32x4*)g)[F.lane + 64 * j]; f32x4 y = v[j] * r * gg;
        if (xcopy) ((f32x4*)xcopy)[F.lane + 64 * j] = v[j];
        if (of32) ((f32x4*)of32)[F.lane + 64 * j] = y;
        if (obf) { u32x2 w; w.x = pk2(y.x, y.y); w.y = pk2(y.z, y.w); ((u32x2*)obf)[F.lane + 64 * j] = w; } }
}
__device__ NOINLINE void ph_norm(Frame F, const float* g, bool final_out) { frame_refresh(F);
    float* X = WSP(float, WS_X); bf16_t* XN = WSP(bf16_t, WS_XN);
    for (int m = F.gw; m < MT; m += F.NGW) norm_row(F, X + (size_t)m * DM, g, final_out ? nullptr : XN + (size_t)m * DM, final_out ? F.out + O_YP + (size_t)m * DM : nullptr, nullptr);
}
__device__ NOINLINE void ph_prologue(Frame F, int only) { frame_refresh(F);
    int base = 0;
    if (only == 0 || only == 1) {
    for (int i = 0; i < N_SSM; ++i) {
        tr_job(F, base, F.in[I_WINE] + (size_t)i * DM * IN_EVEN, IN_EVEN, IN_EVEN, IN_EVEN_PAD, DM, WSP(bf16_t, WS_WINE) + (size_t)i * IN_EVEN_PAD * DM, 0, F.in[I_NME] + (size_t)i * DM);
        tr_job(F, base, F.in[I_WOUTE] + (size_t)i * MIXE * DM, DM, DM, DM, MIXE, WSP(bf16_t, WS_WOUTE) + (size_t)i * DM * MIXE, 0);
    }
    for (int i = 0; i < N_ATT; ++i) {
        tr_job(F, base, F.in[I_WINO] + (size_t)i * DM * IN_ODD, IN_ODD, IN_ODD, IN_ODD_PAD, DM, WSP(bf16_t, WS_WINO) + (size_t)i * IN_ODD_PAD * DM, 0, F.in[I_NMO] + (size_t)i * DM);
        tr_job(F, base, F.in[I_WOUTO] + (size_t)i * DM * DM, DM, DM, DM, DM, WSP(bf16_t, WS_WOUTO) + (size_t)i * DM * DM, 0);
        for (int kv = 0; kv < 2; ++kv) for (int h = 0; h < 2; ++h)
            tr_job(F, base, F.in[I_CW1] + ((size_t)(i * 2 + kv) * 2048 + h * 1024) * 128, 128, 128, 128, 1024, WSP(bf16_t, WS_CW1) + (size_t)(i * 2 + kv) * 256 * 1024, h * 128);
    }
    for (int l = 0; l < DEPTH; ++l) {
        tr_job(F, base, F.in[I_WUP] + (size_t)l * DM * DFF, DFF, DFF, DFF, DM, WSP(bf16_t, WS_WUP) + (size_t)l * DFF * DM, 0, F.in[I_NMLP] + (size_t)l * DM);
        tr_job(F, base, F.in[I_WDN] + (size_t)l * DFF * DM, DM, DM, DM, DFF, WSP(bf16_t, WS_WDN) + (size_t)l * DM * DFF, 0);
    }
    }
    if (only == 0 || only == 2) for (int m = F.gw; m < MT; m += F.NGW) { const float* src = m < MP ? F.in[I_XP] + (size_t)m * DM : F.in[I_XS] + (size_t)(m - MP) * DM; float ss = 0.f;
#pragma unroll
        for (int j = 0; j < 4; ++j) { const f32x4 v = ((const f32x4*)src)[F.lane + 64 * j]; ss += (v.x * v.x + v.y * v.y) + (v.z * v.z + v.w * v.w); ((f32x4*)(WSP(float, WS_X) + (size_t)m * DM))[F.lane + 64 * j] = v;
            u32x2 w; w.x = pk2(v.x, v.y); w.y = pk2(v.z, v.w); ((u32x2*)(WSP(bf16_t, WS_XN) + (size_t)m * DM))[F.lane + 64 * j] = w; }
        ss = wave_sum(ss); if (F.lane < 32) WSP(float, WS_SSQ)[(size_t)m * 32 + F.lane] = F.lane == 0 ? ss : 0.f; }
    if (only != 0 && only != 3) return;
    const int gt = F.bid * NT + F.tid, GT = F.G * NT;
    for (int e = gt; e < N_SSM * S5G * S5P; e += GT) { const int i = e / (S5G * S5P), g = (e / S5P) % S5G, p = e % S5P;
        const float are = F.in[I_S5ARE][e], aim = F.in[I_S5AIM][e], dt = __expf(F.in[I_S5LDT][i * S5G + g]);
        const double rev = (double)aim * (double)dt * 0.15915494309189535, frv = rev - floor(rev); const float th = (float)(frv * 6.283185307179586);
        const float cth = cosf(th), sth = sinf(th), sh = sinf(0.5f * th), cm1 = -2.f * sh * sh, em1 = expm1f(are * dt), mag = em1 + 1.f;
        const float abr = mag * cth, abi = mag * sth, abm1 = em1 * cth + cm1, den = are * are + aim * aim;
        const float fre = (abm1 * are + abi * aim) / den, fim = (abi * are - abm1 * aim) / den;
        WSP(float, WS_S5A)[e * 2] = (float)abr; WSP(float, WS_S5A)[e * 2 + 1] = (float)abi;
        bf16_t* Bt = WSP(bf16_t, WS_S5B) + (size_t)(i * S5G + g) * 128 * 16;
        for (int c = 0; c < 16; ++c) { const float br = F.in[I_S5BRE][(size_t)e * 16 + c], bi = F.in[I_S5BIM][(size_t)e * 16 + c];
            Bt[(2 * p) * 16 + c] = (bf16_t)f2bf((float)(fre * br - fim * bi)); Bt[(2 * p + 1) * 16 + c] = (bf16_t)f2bf((float)(fre * bi + fim * br)); } }
    for (int e = gt; e < N_SSM * S5G * 16 * 128; e += GT) { const int k = e % 128, c = (e / 128) % 16, ig = e / 2048;
        const float v = (k & 1) == 0 ? F.in[I_S5CRE][((size_t)ig * 16 + c) * 64 + (k >> 1)] : -F.in[I_S5CIM][((size_t)ig * 16 + c) * 64 + (k >> 1)];
        WSP(bf16_t, WS_S5C)[e] = (bf16_t)f2bf(v); }
    for (int e = gt; e < NROPE * 8; e += GT) { const int pos = e >> 3, i = e & 7; double inv = 1.0; for (int q = 0; q < i; ++q) inv *= 0.1939227447486858;
        const double ang = (double)pos * inv, rev = ang * 0.15915494309189535, fr = rev - (double)(long long)rev; const float rf = (float)(fr * 6.283185307179586);
        WSP(float, WS_ROPE)[pos * 16 + i] = cosf(rf); WSP(float, WS_ROPE)[pos * 16 + 8 + i] = sinf(rf); }
    for (int e = gt; e < N_ATT * 2 * 64 * 128; e += GT) { const int n = e & 127, d = (e >> 7) & 63, ik = e >> 13; WSP(bf16_t, WS_CW2T)[e] = (bf16_t)f2bf(F.in[I_CW2][((size_t)ik * 128 + n) * 64 + d]); }
    for (int e = gt; e < N_ATT * 2 * 32 * 128; e += GT) { const int n = e % 128, q = (e / 128) % 32, ik = e / 4096; const float* pe = F.in[I_CPOS] + (size_t)ik * 2048 + 64 * q; const float* w = F.in[I_CW1] + ((size_t)ik * 2048 + 64 * q) * 128 + n;
        float s = 0.f;
#pragma unroll 8
        for (int k = 0; k < 64; ++k) s += pe[k] * w[(size_t)k * 128];
        WSP(float, WS_CBIAS)[e] = s; }
}
template <bool SWA = false, bool SWB = false>
__device__ __forceinline__ void mma32_lds(f32x16& acc, const bf16_t* A, int pa, const bf16_t* Bn, int pb, int K, int lane, int arow0 = 0, int brow0 = 0) {
    const int r = lane & 31, h = lane >> 5; const int ar = arow0 + r, br = brow0 + r; const bf16_t* ap = A + (SWA ? ar * pa : r * pa + 8 * h); const bf16_t* bp = Bn + (SWB ? br * pb : r * pb + 8 * h);
    const int fa = (ar >> 3) & 15, fb = (br >> 3) & 15;
    for (int k = 0; k < K; k += 16) { const bf16x8 a = *(const bf16x8*)(SWA ? ap + ((((k >> 3) + h) ^ fa) << 3) : ap + k), b = *(const bf16x8*)(SWB ? bp + ((((k >> 3) + h) ^ fb) << 3) : bp + k); acc = MFMA32(a, b, acc); }
}
__device__ __forceinline__ int swz(int row, int k, int P) { return row * P + ((((k >> 3) ^ ((row >> 3) & 15)) << 3) | (k & 7)); }
__device__ __forceinline__ int crow(int reg, int hi) { return (reg & 3) + 8 * (reg >> 2) + 4 * hi; }
constexpr f32x16 Z16 = {0.f, 0.f, 0.f, 0.f, 0.f, 0.f, 0.f, 0.f, 0.f, 0.f, 0.f, 0.f, 0.f, 0.f, 0.f, 0.f};

template <int ACT  >
__device__ __forceinline__ void gemm_small(Frame& F, const bf16_t* A, const bf16_t* Bt, int N, int K, void* Ov, int ldc, bf16_t* XB, float* ssq) {
    constexpr int SP = 136, SBUF = 96 * SP * 2;
    float* RED = (float*)(F.lds + 2 * SBUF);
    const int lane = F.lane, w = F.wave, r = lane & 31, hi = lane >> 5, nch = K >> 7; constexpr int NPM = MS / 64;
    for (int u = F.bid; u < NPM * (N / 32); u += F.G) { const int pm = u % NPM, pn = u / NPM, row0 = 64 * pm, col0 = 32 * pn;
        const bf16_t* src[3]; int dsto[3];
#pragma unroll
        for (int q = 0; q < 3; ++q) { const int p = F.tid + NT * q, row = p >> 4, c = p & 15; src[q] = (row < 64 ? A + (size_t)(row0 + row) * K : Bt + (size_t)(col0 + row - 64) * K) + 8 * c; dsto[q] = row * SP + 8 * c; }
        constexpr int D = 4;
        u32x4 rg[D][3];
#pragma unroll
        for (int j = 0; j < D; ++j)
#pragma unroll
            for (int q = 0; q < 3; ++q) rg[j][q] = *(const u32x4*)(src[q] + (size_t)j * 128);
        LDS_BARRIER();
#pragma unroll
        for (int q = 0; q < 3; ++q) *(u32x4*)((bf16_t*)F.lds + dsto[q]) = rg[0][q];
        if (D < nch) {
#pragma unroll
            for (int q = 0; q < 3; ++q) rg[0][q] = *(const u32x4*)(src[q] + (size_t)D * 128); }
        LDS_BARRIER();
        f32x16 acc0 = Z16, acc1 = Z16;
        for (int c0 = 0; c0 < nch; c0 += D) {
#pragma unroll
            for (int j = 0; j < D; ++j) { const int c = c0 + j; const bf16_t* sb = (const bf16_t*)(F.lds + (j & 1) * SBUF);
                const bf16x8 bb = *(const bf16x8*)(sb + (64 + r) * SP + 16 * w + 8 * hi), x0 = *(const bf16x8*)(sb + r * SP + 16 * w + 8 * hi), x1 = *(const bf16x8*)(sb + (32 + r) * SP + 16 * w + 8 * hi);
                acc0 = MFMA32(x0, bb, acc0); acc1 = MFMA32(x1, bb, acc1);
                if (c + 1 < nch) { bf16_t* db = (bf16_t*)(F.lds + ((j + 1) & 1) * SBUF); constexpr int DD = D; const int jn = (j + 1) % DD;
#pragma unroll
                    for (int q = 0; q < 3; ++q) *(u32x4*)(db + dsto[q]) = rg[jn][q];
                    if (c + 1 + D < nch) {
#pragma unroll
                        for (int q = 0; q < 3; ++q) rg[jn][q] = *(const u32x4*)(src[q] + (size_t)(c + 1 + D) * 128); }
                    LDS_BARRIER(); } } }
#pragma unroll
        for (int i = 0; i < 16; ++i) { RED[(w * 64 + crow(i, hi)) * 33 + r] = acc0[i]; RED[(w * 64 + 32 + crow(i, hi)) * 33 + r] = acc1[i]; }
        LDS_BARRIER();
        { const int row = F.tid >> 3, c4 = (F.tid & 7) * 4; float v[4];
#pragma unroll
            for (int e = 0; e < 4; ++e) { float s = 0.f;
#pragma unroll
                for (int ww = 0; ww < 8; ++ww) s += RED[(ww * 64 + row) * 33 + c4 + e];
                v[e] = s; }
            const size_t o = (size_t)(row0 + row) * ldc + col0 + c4;
            if (ACT == 2) { f32x4* p = (f32x4*)((float*)Ov + o); f32x4 x = *p; x.x += v[0]; x.y += v[1]; x.z += v[2]; x.w += v[3]; *p = x;
                float ss = (x.x * x.x + x.y * x.y) + (x.z * x.z + x.w * x.w); ss += __shfl_xor(ss, 1); ss += __shfl_xor(ss, 2); ss += __shfl_xor(ss, 4);
                if (XB) { u32x2 pk; pk.x = pk2(x.x, x.y); pk.y = pk2(x.z, x.w); *(u32x2*)(XB + o) = pk; }
                if (ssq && (F.tid & 7) == 0) ssq[(size_t)(row0 + row) * 32 + pn] = ss; }
            else { float rs = 1.f;
                if (ssq) { const f32x4* q = (const f32x4*)(ssq + (size_t)(row0 + row) * 32); float t = 0.f;
#pragma unroll
                    for (int j = 0; j < 8; ++j) { const f32x4 a = q[j]; t += (a.x + a.y) + (a.z + a.w); }
                    rs = 1.f / sqrtf(t * (1.f / 1024.f) + EPS); }
#pragma unroll
                for (int e = 0; e < 4; ++e) { float t = v[e] * rs; if (ACT == 1) { t = t > 0.f ? t : 0.f; t = t * t; } v[e] = t; }
                u32x2 pk; pk.x = pk2(v[0], v[1]); pk.y = pk2(v[2], v[3]); *(u32x2*)((bf16_t*)Ov + o) = pk; } }
    }
}
__device__ NOINLINE void ph_gemm_small(Frame F, int act, const bf16_t* A, const bf16_t* Bt, int N, int K, void* O, int ldc, bf16_t* XB, float* ssq) { frame_refresh(F);
    if (act == 0) gemm_small<0>(F, A, Bt, N, K, O, ldc, XB, ssq); else if (act == 1) gemm_small<1>(F, A, Bt, N, K, O, ldc, XB, ssq); else gemm_small<2>(F, A, Bt, N, K, O, ldc, XB, ssq);
}
__device__ __forceinline__ void s5_prompt_unit(Frame& F, int li, int b, int g) { UNIT_BEGIN(F);
    constexpr int BUP = 132, HBP = 136, BTP = 24, CTP = 136;
    float* BU = (float*)F.lds;
    bf16_t* HB = (bf16_t*)(F.lds + 128 * BUP * 4);
    float* Y = (float*)(F.lds + 128 * BUP * 4 + 128 * HBP * 2);
    bf16_t* BT = (bf16_t*)((unsigned char*)Y + 128 * 20 * 4);
    bf16_t* CT = BT + 128 * BTP;
    float* GW = (float*)(CT + 16 * CTP);
    float* SEG = GW + 576;
    bf16_t* UL = (bf16_t*)(SEG + 8 * 128);
    const bf16_t* PROJ = WSP(bf16_t, WS_PROJ); bf16_t* YMIX = WSP(bf16_t, WS_YMIX);
    const int tid = F.tid, lane = F.lane, w = F.wave, ig = li * S5G + g;
    LDS_BARRIER();
    for (int e = tid; e < 128 * 16; e += NT) BT[(e >> 4) * BTP + (e & 15)] = WSP(bf16_t, WS_S5B)[(size_t)ig * 2048 + e];
    for (int e = tid; e < 16 * 128; e += NT) CT[(e >> 7) * CTP + (e & 127)] = WSP(bf16_t, WS_S5C)[(size_t)ig * 2048 + e];
    for (int e = tid; e < 512; e += NT) GW[e] = F.in[I_GLUW][(size_t)ig * 512 + e];
    if (tid < 32) GW[512 + tid] = F.in[I_GLUB][ig * 32 + tid];
    if (tid < 16) GW[544 + tid] = F.in[I_S5D][li * S5W + g * 16 + tid];
    const float ar = WSP(float, WS_S5A)[(ig * S5P + lane) * 2], ai = WSP(float, WS_S5A)[(ig * S5P + lane) * 2 + 1];
    float a16r = ar, a16i = ai;
#pragma unroll
    for (int q = 0; q < 4; ++q) { const float nr = a16r * a16r - a16i * a16i, ni = 2.f * a16r * a16i; a16r = nr; a16i = ni; }
    float cr = 0.f, ci = 0.f;
    LDS_BARRIER();
    float gl[16], gg[16]; const float gl0 = GW[512 + (tid & 15)], gg0 = GW[528 + (tid & 15)];
#pragma unroll
    for (int c = 0; c < 16; ++c) { gl[c] = GW[c * 32 + (tid & 15)]; gg[c] = GW[c * 32 + 16 + (tid & 15)]; }
    bf16x8 ua[2];
#pragma unroll
    for (int q = 0; q < 2; ++q) { const int tt = (2 * w + q) >> 2; ua[q] = *(const bf16x8*)(PROJ + ((size_t)b * SEQ + 32 * tt + (lane & 31)) * IN_EVEN_PAD + g * 16 + 8 * (lane >> 5)); }
    for (int ch = 0; ch < SEQ / 128; ++ch) {
        const size_t tok0 = (size_t)b * SEQ + ch * 128;
#pragma unroll
        for (int q = 0; q < 2; ++q) { const int tile = 2 * w + q, tt = tile >> 2, st = tile & 3, r = lane & 31, h = lane >> 5;
            const bf16x8 a = ua[q];
            if (st == 0) *(bf16x8*)(UL + (32 * tt + r) * 16 + 8 * h) = a;
            const bf16x8 bb = *(const bf16x8*)(BT + (32 * st + r) * BTP + 8 * h);
            f32x16 d = MFMA32(a, bb, Z16);
#pragma unroll
            for (int i = 0; i < 16; ++i) BU[(32 * tt + crow(i, h)) * BUP + 32 * st + r] = d[i]; }
        if (ch + 1 < SEQ / 128) {
#pragma unroll
            for (int q = 0; q < 2; ++q) { const int tt = (2 * w + q) >> 2; ua[q] = *(const bf16x8*)(PROJ + (tok0 + 128 + 32 * tt + (lane & 31)) * IN_EVEN_PAD + g * 16 + 8 * (lane >> 5)); } }
        LDS_BARRIER();
        float lr[16], lq[16]; { float hr = 0.f, hi = 0.f;
#pragma unroll
            for (int q = 0; q < 16; ++q) { const float br = BU[(16 * w + q) * BUP + 2 * lane], bi = BU[(16 * w + q) * BUP + 2 * lane + 1];
                const float nr = ar * hr - ai * hi + br, ni = ar * hi + ai * hr + bi; hr = nr; hi = ni; lr[q] = hr; lq[q] = hi; }
            SEG[w * 128 + 2 * lane] = hr; SEG[w * 128 + 2 * lane + 1] = hi; }
        LDS_BARRIER();
        float mr = 0.f, mi = 0.f;
#pragma unroll
        for (int v = 0; v < 8; ++v) { if (v == w) { mr = cr; mi = ci; } const float er = SEG[v * 128 + 2 * lane], ei = SEG[v * 128 + 2 * lane + 1];
            const float nr = a16r * cr - a16i * ci + er, ni = a16r * ci + a16i * cr + ei; cr = nr; ci = ni; }
#pragma unroll
        for (int q = 0; q < 16; ++q) { const float nr = ar * mr - ai * mi, ni = ar * mi + ai * mr; mr = nr; mi = ni;
            *(unsigned*)(HB + (16 * w + q) * HBP + 2 * lane) = pk2(lr[q] + mr, lq[q] + mi); }
        LDS_BARRIER();
        { const int row = lane & 15, kq = lane >> 4; f32x4 acc = {0.f, 0.f, 0.f, 0.f};
#pragma unroll
            for (int s4 = 0; s4 < 4; ++s4) { const bf16x8 a = *(const bf16x8*)(HB + (16 * w + row) * HBP + 32 * s4 + 8 * kq), bb = *(const bf16x8*)(CT + row * CTP + 32 * s4 + 8 * kq); acc = MFMA16(a, bb, acc); }
#pragma unroll
            for (int i = 0; i < 4; ++i) { const int t = 16 * w + 4 * kq + i; const float u = bf2f(UL[t * 16 + row]); Y[t * 20 + row] = acc[i] + GW[544 + row] * u; } }
        LDS_BARRIER();
#pragma unroll
        for (int q = 0; q < 4; ++q) { const int t = (tid >> 4) + 32 * q; float lin = gl0, gt = gg0; const f32x4* yp = (const f32x4*)(Y + t * 20);
#pragma unroll
            for (int c4 = 0; c4 < 4; ++c4) { const f32x4 y = yp[c4];
                lin += y.x * gl[4 * c4] + y.y * gl[4 * c4 + 1] + y.z * gl[4 * c4 + 2] + y.w * gl[4 * c4 + 3]; gt += y.x * gg[4 * c4] + y.y * gg[4 * c4 + 1] + y.z * gg[4 * c4 + 2] + y.w * gg[4 * c4 + 3]; }
            YMIX[(tok0 + t) * MIXE + g * 16 + (tid & 15)] = (bf16_t)f2bf_hw(lin * sigmoidf_(gt)); }
    }
    if (w == 0) { float* o = F.out + O_S5P + ((size_t)(li * BATCH + b) * S5G + g) * 128 + lane * 2; o[0] = cr; o[1] = ci; }
}
__device__ __forceinline__ void s5_sample_unit(Frame& F, int li, int b, int g8) { UNIT_BEGIN(F);
    const int lane = F.lane, w = F.wave, g = g8 * 8 + w, ig = li * S5G + g;
    float* HS = (float*)(F.lds + w * 4096);
    float* YS = HS + 512;
    const bf16_t* PROJ = WSP(bf16_t, WS_PROJ); bf16_t* YMIX = WSP(bf16_t, WS_YMIX);
    LDS_BARRIER();
    const float ar = WSP(float, WS_S5A)[(ig * S5P + lane) * 2], ai = WSP(float, WS_S5A)[(ig * S5P + lane) * 2 + 1];
    const float* h0 = F.in[I_S5ST] + (((size_t)li * DEC_BATCH + b) * S5G + g) * 128 + lane * 2;
    float hr = h0[0], hi = h0[1];
    const bf16_t* Bt = WSP(bf16_t, WS_S5B) + (size_t)ig * 2048;
    for (int t = 0; t < DEC_SEQ; ++t) { const bf16_t* u = PROJ + (size_t)(MP + b * DEC_SEQ + t) * IN_EVEN_PAD + g * 16; float br = 0.f, bi = 0.f;
#pragma unroll
        for (int c = 0; c < 16; ++c) { const float uc = bf2f(u[c]); br += bf2f(Bt[(2 * lane) * 16 + c]) * uc; bi += bf2f(Bt[(2 * lane + 1) * 16 + c]) * uc; }
        const float nr = ar * hr - ai * hi + br, ni = ar * hi + ai * hr + bi; hr = nr; hi = ni;
        HS[t * 128 + 2 * lane] = hr; HS[t * 128 + 2 * lane + 1] = hi; }
    { float* o = F.out + O_S5S + (((size_t)li * DEC_BATCH + b) * S5G + g) * 128 + lane * 2; o[0] = hr; o[1] = hi; }
    WAVE_SYNC();
    { const int t = lane >> 4, c = lane & 15; const bf16_t* Ct = WSP(bf16_t, WS_S5C) + (size_t)ig * 2048 + c * 128; float y = 0.f;
        for (int k = 0; k < 128; ++k) y += bf2f(Ct[k]) * HS[t * 128 + k];
        y += F.in[I_S5D][li * S5W + g * 16 + c] * bf2f(PROJ[(size_t)(MP + b * DEC_SEQ + t) * IN_EVEN_PAD + g * 16 + c]);
        YS[t * 16 + c] = y; }
    WAVE_SYNC();
    { const int t = lane >> 4, e = lane & 15; const float* gw = F.in[I_GLUW] + (size_t)ig * 512; float lin = F.in[I_GLUB][ig * 32 + e], gt = F.in[I_GLUB][ig * 32 + 16 + e];
#pragma unroll
        for (int c = 0; c < 16; ++c) { const float y = YS[t * 16 + c]; lin += y * gw[c * 32 + e]; gt += y * gw[c * 32 + 16 + e]; }
        YMIX[(size_t)(MP + b * DEC_SEQ + t) * MIXE + g * 16 + e] = (bf16_t)f2bf(lin * sigmoidf_(gt)); }
}
__device__ __forceinline__ void conv8(const bf16_t* PROJ, size_t tokbase, int t, int ch0, const float* cw, const float* cb, float (&o)[8]) {
#pragma unroll
    for (int e = 0; e < 8; ++e) o[e] = cb[ch0 + e];
#pragma unroll
    for (int k = 0; k < 4; ++k) { const int tt = t - 3 + k; if (tt >= 0) { const u32x4 v = *(const u32x4*)(PROJ + (tokbase + tt) * IN_EVEN_PAD + 1536 + ch0); const float* wk = cw + k * CONVD + ch0;
            o[0] += wk[0] * bflo(v.x); o[1] += wk[1] * bfhi(v.x); o[2] += wk[2] * bflo(v.y); o[3] += wk[3] * bfhi(v.y); o[4] += wk[4] * bflo(v.z); o[5] += wk[5] * bfhi(v.z); o[6] += wk[6] * bflo(v.w); o[7] += wk[7] * bfhi(v.w); } }
#pragma unroll
    for (int e = 0; e < 8; ++e) o[e] = siluf_(o[e]);
}
__device__ __forceinline__ void conv4x8(const bf16_t* PROJ, size_t tokbase, int t0, int ch0, const float* cw, const float* cb, float (&o)[4][8]) {
#pragma unroll
    for (int e = 0; e < 8; ++e) { const float bias = cb[ch0 + e];
#pragma unroll
        for (int i = 0; i < 4; ++i) o[i][e] = bias; }
#pragma unroll
    for (int rr = 0; rr < 7; ++rr) { const int tt = t0 - 3 + rr; u32x4 v = {0u, 0u, 0u, 0u}; if (tt >= 0) v = *(const u32x4*)(PROJ + (tokbase + tt) * IN_EVEN_PAD + 1536 + ch0);
        const float x[8] = {bflo(v.x), bfhi(v.x), bflo(v.y), bfhi(v.y), bflo(v.z), bfhi(v.z), bflo(v.w), bfhi(v.w)};
#pragma unroll
        for (int k = 0; k < 4; ++k) { const int i = rr - k;
            if (i >= 0 && i < 4) { const float* wk = cw + k * CONVD + ch0;
#pragma unroll
                for (int e = 0; e < 8; ++e) o[i][e] += wk[e] * x[e]; } } }
#pragma unroll
    for (int i = 0; i < 4; ++i)
#pragma unroll
        for (int e = 0; e < 8; ++e) o[i][e] = siluf_(o[i][e]);
}
__device__ __forceinline__ void ssd_local_unit(Frame& F, int li, int b, int c, int G) { UNIT_BEGIN(F);
    constexpr int P = 136, RB = 128 * P * 2;
    bf16_t* Bn = (bf16_t*)F.lds; bf16_t* Cm = (bf16_t*)(F.lds + RB); bf16_t* BT = (bf16_t*)(F.lds + 2 * RB); bf16_t* XT = (bf16_t*)(F.lds + 3 * RB); bf16_t* XdT = XT + 64 * P;
    float* DT = (float*)(F.lds + 3 * RB + 2 * 64 * P * 2); float* AC = DT + 4 * 128;
    const bf16_t* PROJ = WSP(bf16_t, WS_PROJ); bf16_t* XBCA = WSP(bf16_t, WS_XBCA);
    const float* cw = F.in[I_CONVW] + (size_t)li * 4 * CONVD; const float* cb = F.in[I_CONVB] + (size_t)li * CONVD;
    const int tid = F.tid, lane = F.lane, w = F.wave; const size_t tokbase = (size_t)b * SEQ; const int t0 = c * CHUNK;
    LDS_BARRIER();
    for (int it = tid; it < 2 * 16 * 32; it += NT) { const int isC = it >> 9, cc = (it >> 5) & 15, lr = it & 31, ch0 = 1024 + isC * 512 + G * 128 + 8 * cc, l0 = 4 * lr; float o[4][8];
        conv4x8(PROJ, tokbase, t0 + l0, ch0, cw, cb, o);
#pragma unroll
        for (int i = 0; i < 4; ++i) { u32x4 pk; pk.x = pk2(o[i][0], o[i][1]); pk.y = pk2(o[i][2], o[i][3]); pk.z = pk2(o[i][4], o[i][5]); pk.w = pk2(o[i][6], o[i][7]);
            if (isC) { *(u32x4*)(Cm + (l0 + i) * P + 8 * cc) = pk; *(u32x4*)(XBCA + (tokbase + t0 + l0 + i) * CONVD + ch0) = pk; } else *(u32x4*)(Bn + (l0 + i) * P + 8 * cc) = pk; }
        if (!isC) {
#pragma unroll
            for (int e = 0; e < 8; ++e) { u32x2 pk; pk.x = pk2(o[0][e], o[1][e]); pk.y = pk2(o[2][e], o[3][e]); *(u32x2*)(BT + swz(8 * cc + e, l0, P)) = pk; } } }
    if (w < 4) { const int head = 4 * G + w; const float bias = F.in[I_DTB][li * SSDH + head], a = -__expf(F.in[I_ALOG][li * SSDH + head]); const int l0 = 2 * lane;
        const float dt0 = softplusf_(bf2f(PROJ[(tokbase + t0 + l0) * IN_EVEN_PAD + 3584 + head]) + bias), dt1 = softplusf_(bf2f(PROJ[(tokbase + t0 + l0 + 1) * IN_EVEN_PAD + 3584 + head]) + bias);
        const float v0 = dt0 * a, v1 = dt1 * a; float sc = v0 + v1;
#pragma unroll
        for (int d = 1; d < 64; d <<= 1) { const float t = __shfl(sc, lane - d); if (lane >= d) sc += t; }
        const float cs1 = sc, cs0 = sc - v1;
        DT[w * 128 + l0] = dt0; DT[w * 128 + l0 + 1] = dt1; AC[w * 128 + l0] = cs0; AC[w * 128 + l0 + 1] = cs1;
        WSP(float, WS_DTV)[(tokbase + t0 + l0) * 16 + head] = dt0; WSP(float, WS_DTV)[(tokbase + t0 + l0 + 1) * 16 + head] = dt1;
        WSP(float, WS_ACS)[(tokbase + t0 + l0) * 16 + head] = cs0; WSP(float, WS_ACS)[(tokbase + t0 + l0 + 1) * 16 + head] = cs1; }
    if (c == NCH - 1) for (int e = tid; e < 3 * 512; e += NT) { const int k = e / 512, j = e % 512, ch = j < 256 ? G * 256 + j : (j < 384 ? 1024 + G * 128 + (j - 256) : 1536 + G * 128 + (j - 384));
        F.out[O_CONVP + ((size_t)(li * BATCH + b) * 3 + k) * CONVD + ch] = bf2f(PROJ[(tokbase + SEQ - 3 + k) * IN_EVEN_PAD + 1536 + ch]); }
    LDS_BARRIER();
    { f32x16 cbt[2];
#pragma unroll
        for (int q = 0; q < 2; ++q) { const int tile = 2 * w + q, ti = tile >> 2, tj = tile & 3; cbt[q] = Z16; if (tj <= ti) mma32_lds(cbt[q], Cm + 32 * ti * P, P, Bn + 32 * tj * P, P, 128, lane); }
        LDS_BARRIER();
#pragma unroll
        for (int q = 0; q < 2; ++q) { const int tile = 2 * w + q, ti = tile >> 2, tj = tile & 3;
#pragma unroll
            for (int i = 0; i < 16; ++i) Bn[(32 * ti + crow(i, lane >> 5)) * P + 32 * tj + (lane & 31)] = (bf16_t)f2bf_hw(cbt[q][i]); } }
    LDS_BARRIER();
    for (int hh = 0; hh < 4; ++hh) { const int head = 4 * G + hh; const float* dt = DT + hh * 128; const float* ac = AC + hh * 128; const float aclast = ac[127];
        if (tid < 256) { const int cc = tid >> 5, lr = tid & 31, ch0 = head * 64 + 8 * cc, l0 = 4 * lr; float o[4][8]; conv4x8(PROJ, tokbase, t0 + l0, ch0, cw, cb, o); float d1[4], d2[4];
#pragma unroll
            for (int i = 0; i < 4; ++i) { d1[i] = dt[l0 + i]; d2[i] = d1[i] * __expf(aclast - ac[l0 + i]);
                u32x4 pk; pk.x = pk2(o[i][0], o[i][1]); pk.y = pk2(o[i][2], o[i][3]); pk.z = pk2(o[i][4], o[i][5]); pk.w = pk2(o[i][6], o[i][7]); *(u32x4*)(XBCA + (tokbase + t0 + l0 + i) * CONVD + ch0) = pk; }
#pragma unroll
            for (int e = 0; e < 8; ++e) { u32x2 p1, p2;
                p1.x = pk2(o[0][e] * d1[0], o[1][e] * d1[1]); p1.y = pk2(o[2][e] * d1[2], o[3][e] * d1[3]); p2.x = pk2(o[0][e] * d2[0], o[1][e] * d2[1]); p2.y = pk2(o[2][e] * d2[2], o[3][e] * d2[3]);
                *(u32x2*)(XT + swz(8 * cc + e, l0, P)) = p1; *(u32x2*)(XdT + swz(8 * cc + e, l0, P)) = p2; } }
        for (int it = tid; it < 128 * 16; it += NT) { const int l = it >> 4, s0 = 8 * (it & 15); u32x4 pk = {0u, 0u, 0u, 0u};
            if (s0 <= l) { const u32x4 cbv = *(const u32x4*)(Bn + l * P + s0); const float al = ac[l]; float v[8] = {bflo(cbv.x), bfhi(cbv.x), bflo(cbv.y), bfhi(cbv.y), bflo(cbv.z), bfhi(cbv.z), bflo(cbv.w), bfhi(cbv.w)};
#pragma unroll
                for (int e = 0; e < 8; ++e) v[e] = (s0 + e <= l) ? v[e] * __expf(al - ac[s0 + e]) : 0.f;
                pk.x = pk2(v[0], v[1]); pk.y = pk2(v[2], v[3]); pk.z = pk2(v[4], v[5]); pk.w = pk2(v[6], v[7]); }
            *(u32x4*)(Cm + l * P + s0) = pk; }
        LDS_BARRIER();
        { const int ti = w >> 1, pj = w & 1; f32x16 acc = Z16; mma32_lds<false, true>(acc, Cm + 32 * ti * P, P, XT, P, 32 * (ti + 1), lane, 0, 32 * pj);
            float* YD = WSP(float, WS_YD);
#pragma unroll
            for (int i = 0; i < 16; ++i) YD[(tokbase + t0 + 32 * ti + crow(i, lane >> 5)) * DM + head * 64 + 32 * pj + (lane & 31)] = acc[i]; }
        { const int pi = w >> 2, nj = w & 3; f32x16 acc = Z16; mma32_lds<true, true>(acc, XdT, P, BT, P, 128, lane, 32 * pi, 32 * nj);
            float* ST = WSP(float, WS_STL) + (((size_t)(b * NCH + c) * SSDH + head) * 64) * 128;
#pragma unroll
            for (int i = 0; i < 16; ++i) ST[(32 * pi + crow(i, lane >> 5)) * 128 + 32 * nj + (lane & 31)] = acc[i]; }
        LDS_BARRIER();
    }
}
__device__ __forceinline__ void ssd_sample_unit(Frame& F, int li, int b, int G) { UNIT_BEGIN(F);
    float* XS = (float*)F.lds; float* BS = XS + 4 * 256; float* CS = BS + 4 * 128; float* DTS = CS + 4 * 128;
    const bf16_t* PROJ = WSP(bf16_t, WS_PROJ); const int tid = F.tid; const size_t tok0 = (size_t)MP + b * DEC_SEQ;
    const float* cw = F.in[I_CONVW] + (size_t)li * 4 * CONVD; const float* cb = F.in[I_CONVB] + (size_t)li * CONVD; const float* cst = F.in[I_CONVST] + ((size_t)li * DEC_BATCH + b) * 3 * CONVD;
    const int p = tid >> 3, n0 = (tid & 7) * 16; const size_t so = (((size_t)li * DEC_BATCH + b) * SSDH + 4 * G) * 8192 + p * 128 + n0;
    f32x4 h[4][4];
#pragma unroll
    for (int hh = 0; hh < 4; ++hh)
#pragma unroll
        for (int j = 0; j < 4; ++j) h[hh][j] = *(const f32x4*)(F.in[I_SSDST] + so + (size_t)hh * 8192 + 4 * j);
    LDS_BARRIER();
    { const int ch = tid < 256 ? G * 256 + tid : (tid < 384 ? 1024 + G * 128 + (tid - 256) : 1536 + G * 128 + (tid - 384)); float xp[7], wk[4];
#pragma unroll
        for (int k = 0; k < 3; ++k) xp[k] = cst[k * CONVD + ch];
#pragma unroll
        for (int t = 0; t < 4; ++t) xp[3 + t] = bf2f(PROJ[(tok0 + t) * IN_EVEN_PAD + 1536 + ch]);
#pragma unroll
        for (int k = 0; k < 4; ++k) wk[k] = cw[k * CONVD + ch];
        const float bias = cb[ch];
#pragma unroll
        for (int t = 0; t < 4; ++t) { float v = bias;
#pragma unroll
            for (int k = 0; k < 4; ++k) v += wk[k] * xp[t + k];
            v = siluf_(v); if (tid < 256) XS[t * 256 + tid] = v; else if (tid < 384) BS[t * 128 + tid - 256] = v; else CS[t * 128 + tid - 384] = v; } }
    if (tid < 16) { const int hh = tid >> 2, t = tid & 3, head = 4 * G + hh; const float dt = softplusf_(bf2f(PROJ[(tok0 + t) * IN_EVEN_PAD + 3584 + head]) + F.in[I_DTB][li * SSDH + head]); DTS[hh * 4 + t] = dt; DTS[16 + hh * 4 + t] = dt * -__expf(F.in[I_ALOG][li * SSDH + head]); }
    if (G == 0) for (int e = tid; e < 3 * CONVD; e += NT) F.out[O_CONVS + ((size_t)li * DEC_BATCH + b) * 3 * CONVD + e] = bf2f(PROJ[(tok0 + 1 + e / CONVD) * IN_EVEN_PAD + 1536 + e % CONVD]);
    LDS_BARRIER();
#pragma unroll
    for (int hh = 0; hh < 4; ++hh) { const int head = 4 * G + hh; const float dsk = F.in[I_SSDD][li * SSDH + head];
#pragma unroll
        for (int t = 0; t < 4; ++t) { const float dec = __expf(DTS[16 + hh * 4 + t]), xv = XS[t * 256 + hh * 64 + p], xd = DTS[hh * 4 + t] * xv; float y = 0.f;
#pragma unroll
            for (int j = 0; j < 4; ++j) { const f32x4 bv = *(const f32x4*)(BS + t * 128 + n0 + 4 * j), cv = *(const f32x4*)(CS + t * 128 + n0 + 4 * j); f32x4 hv = h[hh][j];
                hv.x = dec * hv.x + xd * bv.x; hv.y = dec * hv.y + xd * bv.y; hv.z = dec * hv.z + xd * bv.z; hv.w = dec * hv.w + xd * bv.w; h[hh][j] = hv;
                y += (cv.x * hv.x + cv.y * hv.y) + (cv.z * hv.z + cv.w * hv.w); }
            y = sum8(y);
            if ((tid & 7) == 0) WSP(float, WS_YD)[(tok0 + t) * DM + head * 64 + p] = y + dsk * xv; }
#pragma unroll
        for (int j = 0; j < 4; ++j) *(f32x4*)(F.out + O_SSDS + so + (size_t)hh * 8192 + 4 * j) = h[hh][j]; }
}
__device__ NOINLINE void ph_even_local(Frame F, int li, int only) { frame_refresh(F);
    constexpr int N1 = BATCH * S5G, N2 = BATCH * NCH * SSDG, N3 = DEC_BATCH * SSDG, N4 = DEC_BATCH * 4;
    if (only == 0 || only == 1) for (int u = F.bid; u < N1; u += F.G) s5_prompt_unit(F, li, u / S5G, u % S5G);
    frame_refresh(F);
    if (only == 0 || only == 2) for (int v = F.bid; v < N2; v += F.G) ssd_local_unit(F, li, v / (NCH * SSDG), (v / SSDG) % NCH, v % SSDG);
    frame_refresh(F);
    if (only == 0 || only == 3) for (int v = F.bid; v < N3; v += F.G) ssd_sample_unit(F, li, v / SSDG, v % SSDG);
    frame_refresh(F);
    if (only == 0 || only == 4) for (int v = F.bid; v < N4; v += F.G) s5_sample_unit(F, li, v >> 2, v & 3);
}
__device__ NOINLINE void ph_ssd_carry(Frame F, int li) { frame_refresh(F);
    const int gt = F.bid * NT + F.tid, GT = F.G * NT;
    for (int e = gt; e < BATCH * SSDH * 64 * 32; e += GT) { const int n4 = e & 31, p = (e >> 5) & 63, head = (e >> 11) & 15, b = e >> 15; f32x4 s = {0.f, 0.f, 0.f, 0.f};
        f32x4 loc[NCH]; float dec[NCH];
#pragma unroll
        for (int c = 0; c < NCH; ++c) { const size_t o = ((((size_t)(b * NCH + c) * SSDH + head) * 64) + p) * 128 + 4 * n4; loc[c] = *(const f32x4*)(WSP(float, WS_STL) + o); dec[c] = WSP(float, WS_ACS)[((size_t)b * SEQ + c * CHUNK + CHUNK - 1) * 16 + head]; }
#pragma unroll
        for (int c = 0; c < NCH; ++c) { const size_t o = ((((size_t)(b * NCH + c) * SSDH + head) * 64) + p) * 128 + 4 * n4;
            u32x2 pk; pk.x = pk2(s.x, s.y); pk.y = pk2(s.z, s.w); *(u32x2*)(WSP(bf16_t, WS_STIN) + o) = pk;
            s = s * __expf(dec[c]) + loc[c]; }
        *(f32x4*)(F.out + O_SSDP + (((size_t)(li * BATCH + b) * SSDH + head) * 64 + p) * 128 + 4 * n4) = s; }
}
__device__ __forceinline__ void ssd_fix_unit(Frame& F, int li, int b, int c, int q4) { UNIT_BEGIN(F);
    constexpr int CP = 520, YP = 1032;
    bf16_t* CL = (bf16_t*)F.lds;
    bf16_t* YO = (bf16_t*)(F.lds + 32 * CP * 2);
    float* RS = (float*)(F.lds + 32 * CP * 2 + 32 * YP * 2);
    const bf16_t* PROJ = WSP(bf16_t, WS_PROJ); const bf16_t* XBCA = WSP(bf16_t, WS_XBCA); bf16_t* YMIX = WSP(bf16_t, WS_YMIX);
    const int tid = F.tid, lane = F.lane, w = F.wave, r = lane & 31, hi = lane >> 5; const size_t tok0 = (size_t)b * SEQ + c * CHUNK + 32 * q4;
    LDS_BARRIER();
    for (int it = tid; it < 32 * 64; it += NT) { const int l = it >> 6, cc = it & 63; *(u32x4*)(CL + l * CP + 8 * cc) = *(const u32x4*)(XBCA + (tok0 + l) * CONVD + 1536 + 8 * cc); }
    LDS_BARRIER();
    {
        const bf16_t* ST = WSP(bf16_t, WS_STIN) + (((size_t)(b * NCH + c) * SSDH + 2 * w) * 64) * 128 + (size_t)r * 128 + 8 * hi;
        bf16x8 bb[2][2][8];
        if (c > 0) {
#pragma unroll
            for (int hq = 0; hq < 2; ++hq)
#pragma unroll
                for (int pj = 0; pj < 2; ++pj)
#pragma unroll
                    for (int k = 0; k < 8; ++k) bb[hq][pj][k] = *(const bf16x8*)(ST + (size_t)hq * 8192 + pj * 4096 + 16 * k); }
#pragma unroll
        for (int hq = 0; hq < 2; ++hq) { const int head = 2 * w + hq, G = head >> 2; f32x16 acc0 = Z16, acc1 = Z16; const bf16_t* ap = CL + r * CP + G * 128 + 8 * hi;
            if (c > 0) {
#pragma unroll
                for (int k = 0; k < 8; ++k) { const bf16x8 a = *(const bf16x8*)(ap + 16 * k); acc0 = MFMA32(a, bb[hq][0][k], acc0); acc1 = MFMA32(a, bb[hq][1][k], acc1); } }
#pragma unroll
            for (int i = 0; i < 16; ++i) { YO[crow(i, hi) * YP + head * 64 + r] = (bf16_t)f2bf(acc0[i]); YO[crow(i, hi) * YP + head * 64 + 32 + r] = (bf16_t)f2bf(acc1[i]); } } }
    LDS_BARRIER();
    { const int l = tid >> 4; const size_t tok = tok0 + l; float ss = 0.f;
#pragma unroll
        for (int q0 = 0; q0 < 8; q0 += 4) { u32x4 xx[4], zz[4]; f32x4 d0[4], d1[4]; float ea[4], dsk[4];
#pragma unroll
            for (int j = 0; j < 4; ++j) { const int cc = (tid & 15) + 16 * (q0 + j), ch = 8 * cc, head = cc >> 3; ea[j] = WSP(float, WS_ACS)[tok * 16 + head]; dsk[j] = F.in[I_SSDD][li * SSDH + head];
                xx[j] = *(const u32x4*)(XBCA + tok * CONVD + ch); zz[j] = *(const u32x4*)(PROJ + tok * IN_EVEN_PAD + 512 + ch);
                d0[j] = *(const f32x4*)(WSP(float, WS_YD) + tok * DM + ch); d1[j] = *(const f32x4*)(WSP(float, WS_YD) + tok * DM + ch + 4); }
#pragma unroll
            for (int j = 0; j < 4; ++j) { const int cc = (tid & 15) + 16 * (q0 + j), ch = 8 * cc; const float e_ = __expf(ea[j]), dk = dsk[j]; const u32x4 yo = *(const u32x4*)(YO + l * YP + ch); float v[8];
                v[0] = (bflo(yo.x) * e_ + d0[j].x + dk * bflo(xx[j].x)) * siluf_(bflo(zz[j].x)); v[1] = (bfhi(yo.x) * e_ + d0[j].y + dk * bfhi(xx[j].x)) * siluf_(bfhi(zz[j].x));
                v[2] = (bflo(yo.y) * e_ + d0[j].z + dk * bflo(xx[j].y)) * siluf_(bflo(zz[j].y)); v[3] = (bfhi(yo.y) * e_ + d0[j].w + dk * bfhi(xx[j].y)) * siluf_(bfhi(zz[j].y));
                v[4] = (bflo(yo.z) * e_ + d1[j].x + dk * bflo(xx[j].z)) * siluf_(bflo(zz[j].z)); v[5] = (bfhi(yo.z) * e_ + d1[j].y + dk * bfhi(xx[j].z)) * siluf_(bfhi(zz[j].z));
                v[6] = (bflo(yo.w) * e_ + d1[j].z + dk * bflo(xx[j].w)) * siluf_(bflo(zz[j].w)); v[7] = (bfhi(yo.w) * e_ + d1[j].w + dk * bfhi(xx[j].w)) * siluf_(bfhi(zz[j].w));
#pragma unroll
                for (int e = 0; e < 8; ++e) ss += v[e] * v[e];
                u32x4 pk; pk.x = pk2(v[0], v[1]); pk.y = pk2(v[2], v[3]); pk.z = pk2(v[4], v[5]); pk.w = pk2(v[6], v[7]); *(u32x4*)(YO + l * YP + ch) = pk; } }
        ss += __shfl_xor(ss, 1); ss += __shfl_xor(ss, 2); ss += __shfl_xor(ss, 4); ss += __shfl_xor(ss, 8);
        if ((tid & 15) == 0) RS[l] = 1.f / sqrtf(ss * (1.f / DM) + EPS); }
    LDS_BARRIER();
    { const int l = tid >> 4; const size_t tok = tok0 + l; const float rs = RS[l];
        for (int q = 0; q < 8; ++q) { const int cc = (tid & 15) + 16 * q, ch = 8 * cc; const u32x4 y = *(const u32x4*)(YO + l * YP + ch);
            const f32x4 g0 = *(const f32x4*)(F.in[I_SSDNORM] + li * DM + ch), g1 = *(const f32x4*)(F.in[I_SSDNORM] + li * DM + ch + 4);
            u32x4 pk; pk.x = pk2(bflo(y.x) * rs * g0.x, bfhi(y.x) * rs * g0.y); pk.y = pk2(bflo(y.y) * rs * g0.z, bfhi(y.y) * rs * g0.w); pk.z = pk2(bflo(y.z) * rs * g1.x, bfhi(y.z) * rs * g1.y); pk.w = pk2(bflo(y.w) * rs * g1.z, bfhi(y.w) * rs * g1.w);
            *(u32x4*)(YMIX + tok * MIXE + 512 + ch) = pk; } }
}
__device__ NOINLINE void ph_ssd_fix(Frame F, int li) { frame_refresh(F);
    constexpr int NU = MP / 32;
    for (int u = F.bid; u < NU; u += F.G) { const int q4 = u & 3, c = (u >> 2) % NCH, b = u / (4 * NCH); ssd_fix_unit(F, li, b, c, q4); }
    const bf16_t* PROJ = WSP(bf16_t, WS_PROJ); bf16_t* YMIX = WSP(bf16_t, WS_YMIX);
    for (int m = MP + F.gw; m < MT; m += F.NGW) { float v[16]; float s = 0.f;
#pragma unroll
        for (int j = 0; j < 16; ++j) { const int ch = F.lane + 64 * j; v[j] = WSP(float, WS_YD)[(size_t)m * DM + ch] * siluf_(bf2f(PROJ[(size_t)m * IN_EVEN_PAD + 512 + ch])); s += v[j] * v[j]; }
        const float rs = 1.f / sqrtf(wave_sum(s) * (1.f / DM) + EPS);
#pragma unroll
        for (int j = 0; j < 16; ++j) { const int ch = F.lane + 64 * j; YMIX[(size_t)m * MIXE + 512 + ch] = (bf16_t)f2bf(v[j] * rs * F.in[I_SSDNORM][li * DM + ch]); } }
}
constexpr int CMPROW_S0 = BATCH * NCHK_P * 2;
__device__ NOINLINE void ph_odd_rope(Frame F, int li, bool ident, int only) { frame_refresh(F);
    bf16_t* PROJ = WSP(bf16_t, WS_PROJ); bf16_t* CMPA = WSP(bf16_t, WS_CMPA);
    const int tid = F.tid;
    constexpr int NU_P = MP / 16, NU_S = MS / 16, NU_C = DEC_BATCH * NPAGES;
    constexpr int NU_T = NU_P + NU_S;
    auto item = [&](int u, int it, size_t& tok, int& pos, int& col, bool& rot, bool& isq, int& br, int& iskv, int& g, int& qr, int& tl) { const bool smp = u >= NU_P; const size_t tok0 = smp ? (size_t)MP + (size_t)(u - NU_P) * 16 : (size_t)u * 16;
        tl = it >> 6; const int j = it & 63; tok = tok0 + tl; pos = smp ? PAST + (int)((tok - MP) % DEC_SEQ) : (int)(tok % SEQ);
        isq = j < 16; const int kvi = j - 16, vec = kvi >> 2; qr = kvi & 3; br = vec >> 2; iskv = (vec >> 1) & 1; g = vec & 1;
        col = isq ? j * 64 : 1024 + br * 256 + iskv * 128 + g * 64 + qr * 16; rot = isq || (iskv == 0 && qr == 0); };
    if (only == 0 || only == 1) for (int u0 = F.bid; u0 < NU_T; u0 += 2 * F.G) { u32x4 a[4], c[4]; f32x4 tb[4][4];
#pragma unroll
        for (int q = 0; q < 4; ++q) { const int u = u0 + (q >> 1) * F.G; if (u < NU_T) { size_t tok; int pos, col, br, iskv, g, qr, tl; bool rot, isq; item(u, tid + NT * (q & 1), tok, pos, col, rot, isq, br, iskv, g, qr, tl);
                const u32x4* p = (const u32x4*)(PROJ + tok * IN_ODD_PAD + col); a[q] = p[0]; c[q] = p[1];
                if (rot) { const f32x4* t4 = (const f32x4*)(WSP(float, WS_ROPE) + (size_t)pos * 16); tb[q][0] = t4[0]; tb[q][1] = t4[1]; tb[q][2] = t4[2]; tb[q][3] = t4[3]; } } }
#pragma unroll
        for (int q = 0; q < 4; ++q) { const int u = u0 + (q >> 1) * F.G; if (u < NU_T) { size_t tok; int pos, col, br, iskv, g, qr, tl; bool rot, isq; item(u, tid + NT * (q & 1), tok, pos, col, rot, isq, br, iskv, g, qr, tl);
                const bool smp = u >= NU_P; u32x4 av = a[q], cv = c[q];
                if (rot) { f32x4 c0 = tb[q][0], c1 = tb[q][1], s0 = tb[q][2], s1 = tb[q][3];
                    if (ident) { c0 = (f32x4){1.f, 1.f, 1.f, 1.f}; c1 = c0; s0 = (f32x4){0.f, 0.f, 0.f, 0.f}; s1 = s0; }
                    const float cs[8] = {c0.x, c0.y, c0.z, c0.w, c1.x, c1.y, c1.z, c1.w}, sn[8] = {s0.x, s0.y, s0.z, s0.w, s1.x, s1.y, s1.z, s1.w};
                    const float x1[8] = {bflo(av.x), bfhi(av.x), bflo(av.y), bfhi(av.y), bflo(av.z), bfhi(av.z), bflo(av.w), bfhi(av.w)}, x2[8] = {bflo(cv.x), bfhi(cv.x), bflo(cv.y), bfhi(cv.y), bflo(cv.z), bfhi(cv.z), bflo(cv.w), bfhi(cv.w)};
                    av.x = pk2(x1[0] * cs[0] - x2[0] * sn[0], x1[1] * cs[1] - x2[1] * sn[1]); av.y = pk2(x1[2] * cs[2] - x2[2] * sn[2], x1[3] * cs[3] - x2[3] * sn[3]);
                    av.z = pk2(x1[4] * cs[4] - x2[4] * sn[4], x1[5] * cs[5] - x2[5] * sn[5]); av.w = pk2(x1[6] * cs[6] - x2[6] * sn[6], x1[7] * cs[7] - x2[7] * sn[7]);
                    cv.x = pk2(x2[0] * cs[0] + x1[0] * sn[0], x2[1] * cs[1] + x1[1] * sn[1]); cv.y = pk2(x2[2] * cs[2] + x1[2] * sn[2], x2[3] * cs[3] + x1[3] * sn[3]);
                    cv.z = pk2(x2[4] * cs[4] + x1[4] * sn[4], x2[5] * cs[5] + x1[5] * sn[5]); cv.w = pk2(x2[6] * cs[6] + x1[6] * sn[6], x2[7] * cs[7] + x1[7] * sn[7]);
                    u32x4* p = (u32x4*)(PROJ + tok * IN_ODD_PAD + col); p[0] = av; p[1] = cv; }
                if (!isq) { const int jo = iskv * 128 + g * 64 + qr * 16; float* dst = nullptr;
                    if (!smp) { const int b = (int)(tok / SEQ), t = (int)(tok % SEQ);
                        if (br == 0) dst = F.out + O_CMPP + ((size_t)li * MP + tok) * 256 + jo; else if (br == 1) dst = F.out + O_SELP + ((size_t)li * MP + tok) * 256 + jo;
                        else if (t >= SEQ - WKEEP_P) dst = F.out + O_WINP + (((size_t)li * BATCH + b) * WKEEP_P + (t - (SEQ - WKEEP_P))) * 256 + jo;
                    } else { const size_t ts = tok - MP; const int b = (int)(ts / DEC_SEQ), t = (int)(ts % DEC_SEQ);
                        if (br == 0) dst = F.out + O_CMPS + ((size_t)li * MS + ts) * 256 + jo; else if (br == 1) dst = F.out + O_SELS + ((size_t)li * MS + ts) * 256 + jo;
                        else dst = F.out + O_WINS + (((size_t)li * DEC_BATCH + b) * WKEEP_S + (WKEEP_S - DEC_SEQ + t)) * 256 + jo; }
                    if (dst) { ((f32x4*)dst)[0] = (f32x4){bflo(av.x), bfhi(av.x), bflo(av.y), bfhi(av.y)}; ((f32x4*)dst)[1] = (f32x4){bflo(av.z), bfhi(av.z), bflo(av.w), bfhi(av.w)};
                        ((f32x4*)dst)[2] = (f32x4){bflo(cv.x), bfhi(cv.x), bflo(cv.y), bfhi(cv.y)}; ((f32x4*)dst)[3] = (f32x4){bflo(cv.z), bfhi(cv.z), bflo(cv.w), bfhi(cv.w)}; }
                    if (!smp && br == 0) { u32x4* cd = (u32x4*)(CMPA + ((size_t)iskv * CMPROWS_PAD + (size_t)u * 2 + g) * 1024 + tl * 64 + qr * 16); cd[0] = av; cd[1] = cv; } } } }
    }
    if (only == 0 || only == 2) for (int v = F.bid; v < NU_C; v += F.G) { const int b = v / NPAGES, pg = v % NPAGES; const int page = ((const int*)F.in[I_PT])[b * NPAGES + pg];
        const int pos = tid >> 5, kv = (tid >> 4) & 1, g = (tid >> 3) & 1, c8 = tid & 7;
        const float* src = F.in[I_CCMP] + (((size_t)li * NPOOL + page) * PAGE + pos) * 256 + kv * 128 + g * 64 + 8 * c8; f32x4 va[8], vc[8];
#pragma unroll
        for (int j8 = 0; j8 < 8; ++j8) { va[j8] = ((const f32x4*)(src + (size_t)j8 * 16 * 256))[0]; vc[j8] = ((const f32x4*)(src + (size_t)j8 * 16 * 256))[1]; }
#pragma unroll
        for (int j8 = 0; j8 < 8; ++j8) { const size_t R = (size_t)CMPROW_S0 + ((size_t)b * NCHK_S + pg * 8 + j8) * 2 + g;
            u32x4 pk; pk.x = pk2(va[j8].x, va[j8].y); pk.y = pk2(va[j8].z, va[j8].w); pk.z = pk2(vc[j8].x, vc[j8].y); pk.w = pk2(vc[j8].z, vc[j8].w);
            *(u32x4*)(CMPA + ((size_t)kv * CMPROWS_PAD + R) * 1024 + pos * 64 + 8 * c8) = pk; }
    }
}
__device__ NOINLINE void ph_win_copy(Frame F, int li, int blk, int nblk) { frame_refresh(F);
    const unsigned gt = (unsigned)(blk * NT + F.tid), GT = (unsigned)(nblk * NT); constexpr unsigned NOLD = WKEEP_S - DEC_SEQ;
    constexpr unsigned NIT = (unsigned)DEC_BATCH * NOLD * 64; static_assert((size_t)DEC_BATCH * NOLD * 64 < (1ull << 31), "32-bit item index");
    const float* srcb = F.in[I_WINST] + ((size_t)li * DEC_BATCH * WBUF + (WBUF + DEC_SEQ - WKEEP_S)) * 256; float* dstb = F.out + O_WINS + (size_t)li * DEC_BATCH * WKEEP_S * 256;
    for (unsigned e0 = gt; e0 < NIT; e0 += 8u * GT) { f32x4 v[8];
#pragma unroll
        for (int k = 0; k < 8; ++k) { const unsigned e = e0 + (unsigned)k * GT; if (e < NIT) { const unsigned c4 = e & 63u, rb = e >> 6, b = rb / NOLD, r = rb - b * NOLD; v[k] = *(const f32x4*)(srcb + ((size_t)b * WBUF + r) * 256 + 4 * c4); } }
#pragma unroll
        for (int k = 0; k < 8; ++k) { const unsigned e = e0 + (unsigned)k * GT; if (e < NIT) { const unsigned c4 = e & 63u, rb = e >> 6, b = rb / NOLD, r = rb - b * NOLD; *(f32x4*)(dstb + ((size_t)b * WKEEP_S + r) * 256 + 4 * c4) = v[k]; } } }
}
__device__ NOINLINE void ph_cmp_finish(Frame F, int li) { frame_refresh(F);
    constexpr int HP = 136;
    bf16_t* HID = (bf16_t*)F.lds; bf16_t* W2T = HID + 128 * HP; float* CB = (float*)(W2T + 64 * HP);
    const bf16_t* AB = WSP(bf16_t, WS_CMPAB); bf16_t* KC = WSP(bf16_t, WS_KC); const int tid = F.tid, lane = F.lane, w = F.wave;
    constexpr int NU = 2 * (BATCH + DEC_BATCH) * 2;
    for (int u = F.bid; u < NU; u += F.G) { const int g = u & 1, seqa = (u >> 1) % (BATCH + DEC_BATCH), kv = u / (2 * (BATCH + DEC_BATCH));
        const bool smp = seqa >= BATCH; const int ncmp = smp ? NCMP_S : NCMP_P; const int Rb0 = smp ? CMPROW_S0 + (seqa - BATCH) * NCHK_S * 2 + g : seqa * NCHK_P * 2 + g;
        LDS_BARRIER();
        for (int e = tid; e < 128 * 64; e += NT) { const int n = e >> 6, d = e & 63; W2T[d * HP + n] = (bf16_t)f2bf(F.in[I_CW2][((size_t)(li * 2 + kv) * 128 + n) * 64 + d]); }
        if (tid < 128) { float sb = 0.f; for (int q = 0; q < 32; ++q) sb += WSP(float, WS_CBIAS)[((size_t)(li * 2 + kv) * 32 + q) * 128 + tid]; CB[tid] = sb; }
        LDS_BARRIER();
        for (int it = tid; it < 128 * 16; it += NT) { const int i = it >> 4, c8 = it & 15; u32x4 pk = {0u, 0u, 0u, 0u};
            if (i < ncmp) { const u32x4 a = *(const u32x4*)(AB + ((size_t)kv * CMPROWS_PAD + Rb0 + 2 * i) * 256 + 8 * c8), bb = *(const u32x4*)(AB + ((size_t)kv * CMPROWS_PAD + Rb0 + 2 * i + 2) * 256 + 128 + 8 * c8);
                const float* cb = CB + 8 * c8;
                pk.x = pk2(siluf_(bflo(a.x) + bflo(bb.x) + cb[0]), siluf_(bfhi(a.x) + bfhi(bb.x) + cb[1])); pk.y = pk2(siluf_(bflo(a.y) + bflo(bb.y) + cb[2]), siluf_(bfhi(a.y) + bfhi(bb.y) + cb[3]));
                pk.z = pk2(siluf_(bflo(a.z) + bflo(bb.z) + cb[4]), siluf_(bfhi(a.z) + bfhi(bb.z) + cb[5])); pk.w = pk2(siluf_(bflo(a.w) + bflo(bb.w) + cb[6]), siluf_(bfhi(a.w) + bfhi(bb.w) + cb[7])); }
            *(u32x4*)(HID + i * HP + 8 * c8) = pk; }
        LDS_BARRIER();
        { const int ti = w >> 1, tj = w & 1; f32x16 acc = Z16; mma32_lds(acc, HID + 32 * ti * HP, HP, W2T + 32 * tj * HP, HP, 128, lane);
#pragma unroll
            for (int q = 0; q < 16; ++q) { const int i = 32 * ti + crow(q, lane >> 5); if (i < ncmp) KC[(((size_t)kv * (BATCH + DEC_BATCH) + seqa) * 128 + i) * 128 + g * 64 + 32 * tj + (lane & 31)] = (bf16_t)f2bf(acc[q]); } }
    }
}
constexpr float ATT_SCALE = 0.125f, NEGB = -1e30f;
__device__ __forceinline__ int vtoff(int d, int pc, int VP, int xm) { return d * VP + ((((pc >> 3) ^ ((d >> 3) & xm)) << 3) | (pc & 7)); }
__device__ __forceinline__ int vperm(int key) { const int k16 = key & 15; return (key & ~15) | (8 * ((k16 >> 2) & 1) + 4 * (k16 >> 3) + (k16 & 3)); }
__device__ __forceinline__ bf16x8 packp(const f32x16& p, int s2) { u32x4 w; w.x = pk2(p[8 * s2], p[8 * s2 + 1]); w.y = pk2(p[8 * s2 + 2], p[8 * s2 + 3]); w.z = pk2(p[8 * s2 + 4], p[8 * s2 + 5]); w.w = pk2(p[8 * s2 + 6], p[8 * s2 + 7]); return __builtin_bit_cast(bf16x8, w); }
constexpr float LOG2E = 1.4426950408889634f, MINIT = -1e29f;
template <class MaskF>
__device__ __forceinline__ void attn_sub32(const bf16_t* Ks, int KP, const bf16_t* VT, int VP, int cg0  , int xm  , const bf16x8 (&qf)[4], float& m, float& l, f32x16 (&o)[2], int lane, bool full, MaskF mask) {
    const int r = lane & 31, hi = lane >> 5; f32x16 s = Z16;
#pragma unroll
    for (int ks = 0; ks < 4; ++ks) { const bf16x8 a = *(const bf16x8*)(Ks + r * KP + 16 * ks + 8 * hi); s = MFMA32(a, qf[ks], s); }
    if (!full) {
#pragma unroll
        for (int i = 0; i < 16; ++i) s[i] = mask(crow(i, hi)) ? s[i] : NEGB; }
#pragma unroll
    for (int i = 0; i < 16; i += 2) { const f32x2 a = (f32x2){s[i], s[i + 1]} * (f32x2){LOG2E, LOG2E}; s[i] = a.x; s[i + 1] = a.y; }
    float mx = fmaxf(fmaxf(s[0], s[1]), s[2]);
#pragma unroll
    for (int i = 3; i < 15; i += 2) mx = fmaxf(fmaxf(mx, s[i]), s[i + 1]);
    mx = fmaxf(mx, s[15]); mx = fmaxf(mx, __shfl_xor(mx, 32));
    const float mn = fmaxf(m, mx);
    { const float alpha = EXP2F(m - mn); l *= alpha; o[0] = o[0] * alpha; o[1] = o[1] * alpha; m = mn; }
    f32x2 ps2 = {0.f, 0.f};
#pragma unroll
    for (int i = 0; i < 16; i += 2) { const f32x2 t = (f32x2){s[i], s[i + 1]} - (f32x2){mn, mn}; const f32x2 p = {EXP2F(t.x), EXP2F(t.y)}; s[i] = p.x; s[i + 1] = p.y; ps2 += p; }
    l += ps2.x + ps2.y;
    const bf16x8 p0 = packp(s, 0), p1 = packp(s, 1);
#pragma unroll
    for (int dt = 0; dt < 2; ++dt) { const int d = 32 * dt + r, f = (d >> 3) & xm; const bf16_t* vp = VT + d * VP;
        o[dt] = MFMA32(*(const bf16x8*)(vp + (((cg0 + hi) ^ f) << 3)), p0, o[dt]); o[dt] = MFMA32(*(const bf16x8*)(vp + (((cg0 + 2 + hi) ^ f) << 3)), p1, o[dt]); }
}
template <class MaskF>
__device__ __forceinline__ void attn_tile64(const bf16_t* KB, const bf16_t* VB, const bf16x8 (&qf)[4], float& m, float& l, f32x16 (&o)[2], int lane, bool full0, bool full1, MaskF mask  ) {
    constexpr int KP = 72, VP = 72; const int r = lane & 31, hi = lane >> 5;
    bf16x8 kf[8];
#pragma unroll
    for (int q = 0; q < 8; ++q) kf[q] = *(const bf16x8*)(KB + (32 * (q >> 2) + r) * KP + 16 * (q & 3) + 8 * hi);
    f32x16 s0 = Z16, s1 = Z16;
#pragma unroll
    for (int ks = 0; ks < 4; ++ks) { s0 = MFMA32(kf[ks], qf[ks], s0); s1 = MFMA32(kf[4 + ks], qf[ks], s1); }
    if (!full0) {
#pragma unroll
        for (int i = 0; i < 16; ++i) s0[i] = mask(0, crow(i, hi)) ? s0[i] : NEGB; }
    if (!full1) {
#pragma unroll
        for (int i = 0; i < 16; ++i) s1[i] = mask(1, crow(i, hi)) ? s1[i] : NEGB; }
#pragma unroll
    for (int i = 0; i < 16; i += 2) { const f32x2 a = (f32x2){s0[i], s0[i + 1]} * (f32x2){LOG2E, LOG2E}, c = (f32x2){s1[i], s1[i + 1]} * (f32x2){LOG2E, LOG2E}; s0[i] = a.x; s0[i + 1] = a.y; s1[i] = c.x; s1[i + 1] = c.y; }
    float mx = fmaxf(fmaxf(s0[0], s1[0]), s0[1]);
#pragma unroll
    for (int i = 1; i < 15; ++i) mx = fmaxf(fmaxf(mx, s1[i]), s0[i + 1]);
    mx = fmaxf(mx, s1[15]); mx = fmaxf(mx, __shfl_xor(mx, 32));
    const float mn = fmaxf(m, mx);
    { const float alpha = EXP2F(m - mn); l *= alpha; o[0] = o[0] * alpha; o[1] = o[1] * alpha; m = mn; }
    f32x2 ps2 = {0.f, 0.f};
#pragma unroll
    for (int i = 0; i < 16; i += 2) { const f32x2 t0 = (f32x2){s0[i], s0[i + 1]} - (f32x2){mn, mn}, t1 = (f32x2){s1[i], s1[i + 1]} - (f32x2){mn, mn};
        const f32x2 p0 = {EXP2F(t0.x), EXP2F(t0.y)}, p1 = {EXP2F(t1.x), EXP2F(t1.y)}; s0[i] = p0.x; s0[i + 1] = p0.y; s1[i] = p1.x; s1[i + 1] = p1.y; ps2 += p0; ps2 += p1; }
    l += ps2.x + ps2.y;
    const bf16x8 p00 = packp(s0, 0), p01 = packp(s0, 1), p10 = packp(s1, 0), p11 = packp(s1, 1);
#pragma unroll
    for (int dt = 0; dt < 2; ++dt) { const int d = 32 * dt + r, f = (d >> 3) & 7; const bf16_t* vp = VB + d * VP;
        const bf16x8 v0 = *(const bf16x8*)(vp + (((0 + hi) ^ f) << 3)), v1 = *(const bf16x8*)(vp + (((2 + hi) ^ f) << 3)), v2 = *(const bf16x8*)(vp + (((4 + hi) ^ f) << 3)), v3 = *(const bf16x8*)(vp + (((6 + hi) ^ f) << 3));
        o[dt] = MFMA32(v0, p00, o[dt]); o[dt] = MFMA32(v1, p01, o[dt]); o[dt] = MFMA32(v2, p10, o[dt]); o[dt] = MFMA32(v3, p11, o[dt]); }
}
__device__ __forceinline__ void scale_q(bf16x8 (&qf)[4]) {
#pragma unroll
    for (int ks = 0; ks < 4; ++ks) { u32x4 w = __builtin_bit_cast(u32x4, qf[ks]);
        w.x = pk2(bflo(w.x) * ATT_SCALE, bfhi(w.x) * ATT_SCALE); w.y = pk2(bflo(w.y) * ATT_SCALE, bfhi(w.y) * ATT_SCALE); w.z = pk2(bflo(w.z) * ATT_SCALE, bfhi(w.z) * ATT_SCALE); w.w = pk2(bflo(w.w) * ATT_SCALE, bfhi(w.w) * ATT_SCALE);
        qf[ks] = __builtin_bit_cast(bf16x8, w); }
}
constexpr int KTP = 72, VTP = 136, A_KT = 0, A_VT = A_KT + 128 * KTP * 2, A_SHARED_END = 2 * 18432;
constexpr int PKP = 72, PVP = 40, A_PRIV = 0, PRIV_BYTES = 32 * PKP * 2 + 64 * PVP * 2, A_PRIV_END = A_PRIV + 8 * PRIV_BYTES;
constexpr int A_PS = (A_PRIV_END > A_SHARED_END ? A_PRIV_END : A_SHARED_END), A_SC = A_PS + 32 * 128 * 4, A_SM = A_SC + 32 * 64 * 4, A_TOT = A_SM + 512, A_GT = A_TOT + 32 * 64 * 4, A_END = A_GT + 512;
static_assert(A_END <= LDS_MISC && 8 * 32 * 66 * 4 <= A_PS, "attention LDS map");
template <class RowF> __device__ __forceinline__ void stage_kv_bf16(Frame& F, int nk, RowF rowfn) {
    bf16_t* KT = (bf16_t*)(F.lds + A_KT); bf16_t* VT = (bf16_t*)(F.lds + A_VT);
    for (int it = F.tid; it < nk * 8; it += NT) { const int key = it >> 3, c = it & 7; const bf16_t* kp; const bf16_t* vp; rowfn(key, kp, vp);
        u32x4 kk = {0u, 0u, 0u, 0u}, vv = {0u, 0u, 0u, 0u}; if (kp) { kk = *(const u32x4*)(kp + 8 * c); vv = *(const u32x4*)(vp + 8 * c); }
        *(u32x4*)(KT + key * KTP + 8 * c) = kk; const int pc = vperm(key); bf16_t* vt = VT + vtoff(8 * c, pc, VTP, 7);
        vt[0] = (bf16_t)(vv.x & 0xffffu); vt[VTP] = (bf16_t)(vv.x >> 16); vt[2 * VTP] = (bf16_t)(vv.y & 0xffffu); vt[3 * VTP] = (bf16_t)(vv.y >> 16);
        vt[4 * VTP] = (bf16_t)(vv.z & 0xffffu); vt[5 * VTP] = (bf16_t)(vv.z >> 16); vt[6 * VTP] = (bf16_t)(vv.w & 0xffffu); vt[7 * VTP] = (bf16_t)(vv.w >> 16); }
}
__device__ __forceinline__ void attn_cmp(Frame& F, const bf16x8 (&qf)[4], int pos, int ncmp, int ps_row, int imax_wave, f32x16 (&o)[2]) {
    const bf16_t* KT = (const bf16_t*)(F.lds + A_KT); const bf16_t* VT = (const bf16_t*)(F.lds + A_VT); float* PS = (float*)(F.lds + A_PS);
    const int lane = F.lane, r = lane & 31, hi = lane >> 5; int imax = pos >= 31 ? ((pos - 31) >> 4) : -1; if (imax > ncmp - 1) imax = ncmp - 1;
    constexpr int NSUB = ((NCMP_P > NCMP_S ? NCMP_P : NCMP_S) + 31) / 32;
    const int nsub = imax_wave < 0 ? 0 : ((imax_wave >> 5) + 1 < NSUB ? (imax_wave >> 5) + 1 : NSUB);
    float mx = MINIT, sum = 0.f;
    for (int sb = 0; sb < nsub; ++sb) { f32x16 s = Z16;
#pragma unroll
        for (int ks = 0; ks < 4; ++ks) { const bf16x8 a = *(const bf16x8*)(KT + (32 * sb + r) * KTP + 16 * ks + 8 * hi); s = MFMA32(a, qf[ks], s); }
        float tm = NEGB;
#pragma unroll
        for (int i = 0; i < 16; ++i) { const float v = (32 * sb + crow(i, hi) <= imax) ? s[i] : NEGB; s[i] = v; tm = fmaxf(tm, v); }
        const float mn = fmaxf(mx, tm), nb = -mn * LOG2E; float ps = 0.f;
#pragma unroll
        for (int i = 0; i < 16; ++i) ps += EXP2F(fmaf(s[i], LOG2E, nb));
        sum = sum * EXP2F((mx - mn) * LOG2E) + ps; mx = mn; }
    { const float mo = __shfl_xor(mx, 32), so = __shfl_xor(sum, 32), M = fmaxf(mx, mo); sum = sum * EXP2F((mx - M) * LOG2E) + so * EXP2F((mo - M) * LOG2E); mx = M; }
    const float inv = sum > 0.f ? 1.f / sum : 0.f, nb = -mx * LOG2E;
    o[0] = Z16; o[1] = Z16;
    for (int sb = 0; sb < NSUB; ++sb) {
        if (sb < nsub) { f32x16 s = Z16;
#pragma unroll
            for (int ks = 0; ks < 4; ++ks) { const bf16x8 a = *(const bf16x8*)(KT + (32 * sb + r) * KTP + 16 * ks + 8 * hi); s = MFMA32(a, qf[ks], s); }
#pragma unroll
            for (int i = 0; i < 16; ++i) s[i] = (32 * sb + crow(i, hi) <= imax) ? EXP2F(fmaf(s[i], LOG2E, nb)) * inv : 0.f;
            const bf16x8 p0 = packp(s, 0), p1 = packp(s, 1);
#pragma unroll
            for (int dt = 0; dt < 2; ++dt) { const int d = 32 * dt + r, f = (d >> 3) & 7; const bf16_t* vp = VT + d * VTP; o[dt] = MFMA32(*(const bf16x8*)(vp + (((4 * sb + hi) ^ f) << 3)), p0, o[dt]); o[dt] = MFMA32(*(const bf16x8*)(vp + (((4 * sb + 2 + hi) ^ f) << 3)), p1, o[dt]); }
#pragma unroll
            for (int i = 0; i < 16; ++i) { const float v = sum8(s[i]); if ((r & 7) == 0) PS[ps_row * 128 + 32 * sb + crow(i, hi)] = v; }
        } else if ((r & 7) == 0) {
#pragma unroll
            for (int i = 0; i < 16; ++i) PS[ps_row * 128 + 32 * sb + crow(i, hi)] = 0.f; } }
}
__device__ __forceinline__ void attn_topk(Frame& F, int ntok, int pos0, int ncmp, int nslc) {
    const float* PS = (const float*)(F.lds + A_PS); float* SC = (float*)(F.lds + A_SC); unsigned* SM = (unsigned*)(F.lds + A_SM);
    const int kk = TOPK < nslc ? TOPK : nslc;
    for (int e = F.tid; e < ntok * 64; e += NT) { const int tl = e >> 6, j = e & 63; if (j < 2) SM[tl * 2 + j] = 0u; if (tl == 0 && j < 2) SM[64 + j] = 0u;
        if (j < nslc) { const int pos = pos0 + tl, qb = pos >> 6; float imp = 0.f;
            for (int ci = 4 * j - 1; ci <= 4 * j + 3; ++ci) if (ci >= 0 && ci < ncmp) imp += PS[tl * 128 + ci];
            const bool valid = j * 64 <= pos, forced = (j == 0) || (j == qb) || (j == qb - 1);
            SC[tl * 64 + j] = valid ? imp + (forced ? 1e4f : 0.f) : NEGB; } }
    LDS_BARRIER();
    for (int e = F.tid; e < ntok * 64; e += NT) { const int tl = e >> 6, j = e & 63;
        if (j < nslc) { const float v = SC[tl * 64 + j]; int rank = 0;
            for (int j2 = 0; j2 < nslc; ++j2) { const float v2 = SC[tl * 64 + j2]; rank += (v2 > v || (v2 == v && j2 < j)) ? 1 : 0; }
            if (rank < kk) { atomicOr(&SM[tl * 2 + (j >> 5)], 1u << (j & 31)); atomicOr(&SM[64 + (j >> 5)], 1u << (j & 31)); } } }
    LDS_BARRIER();
}
__device__ __forceinline__ void store_o(bf16_t* dst, const f32x16 (&t)[2], int hi) {
#pragma unroll
    for (int dt = 0; dt < 2; ++dt)
#pragma unroll
        for (int q = 0; q < 4; ++q) { u32x2 w; w.x = pk2(t[dt][4 * q], t[dt][4 * q + 1]); w.y = pk2(t[dt][4 * q + 2], t[dt][4 * q + 3]); *(u32x2*)(dst + 32 * dt + 8 * q + 4 * hi) = w; }
}
__device__ __forceinline__ void attn_prompt_unit(Frame& F, int li, int b, int g, int qt, int mode) { UNIT_BEGIN(F);
    const bf16_t* PROJ = WSP(bf16_t, WS_PROJ); const bf16_t* KC = WSP(bf16_t, WS_KC); bf16_t* OUT = WSP(bf16_t, WS_YMIX);
    const bf16_t* KT = (const bf16_t*)(F.lds + A_KT); const bf16_t* VT = (const bf16_t*)(F.lds + A_VT); const unsigned* SM = (const unsigned*)(F.lds + A_SM);
    const int lane = F.lane, w = F.wave, r = lane & 31, hi = lane >> 5, t0 = 32 * qt, tl = 4 * w + (r >> 3), pos = t0 + tl, hd = g * 8 + (r & 7); const size_t tok = (size_t)b * SEQ + pos;
    bf16x8 qf[4];
#pragma unroll
    for (int ks = 0; ks < 4; ++ks) qf[ks] = *(const bf16x8*)(PROJ + tok * IN_ODD_PAD + hd * 64 + 16 * ks + 8 * hi);
    scale_q(qf);
    float gate[3];
#pragma unroll
    for (int q = 0; q < 3; ++q) gate[q] = sigmoidf_(bf2f(PROJ[tok * IN_ODD_PAD + 1792 + hd * 3 + q]));
    LDS_BARRIER();
    stage_kv_bf16(F, 128, [&](int key, const bf16_t*& kp, const bf16_t*& vp) { if (key < NCMP_P) { kp = KC + (((size_t)0 * (BATCH + DEC_BATCH) + b) * 128 + key) * 128 + g * 64; vp = KC + (((size_t)1 * (BATCH + DEC_BATCH) + b) * 128 + key) * 128 + g * 64; } else { kp = nullptr; vp = nullptr; } });
    LDS_BARRIER();
    f32x16 tot[2], o[2];
    attn_cmp(F, qf, pos, NCMP_P, tl, (t0 + 4 * w + 3 >= 31) ? ((t0 + 4 * w + 3 - 31) >> 4) : -1, o);
    tot[0] = o[0] * gate[0]; tot[1] = o[1] * gate[0];
    LDS_BARRIER();
    attn_topk(F, 32, t0, NCMP_P, NSLC_P);
    const unsigned long long selm = (unsigned long long)SM[tl * 2] | ((unsigned long long)SM[tl * 2 + 1] << 32), orm = (unsigned long long)SM[64] | ((unsigned long long)SM[65] << 32);
    const int skey = F.tid >> 3, sc8 = F.tid & 7, spc = vperm(skey);
#define TILE_LOAD(j, colk, colv) do { const size_t kt_ = (size_t)b * SEQ + 64 * (j) + skey; rk = *(const u32x4*)(PROJ + kt_ * IN_ODD_PAD + (colk) + g * 64 + 8 * sc8); rv = *(const u32x4*)(PROJ + kt_ * IN_ODD_PAD + (colv) + g * 64 + 8 * sc8); } while (0)
#define TILE_WRITE(bufi) do { bf16_t* kb_ = (bf16_t*)(F.lds + (bufi) * 18432); bf16_t* vt_ = kb_ + 64 * 72 + vtoff(8 * sc8, spc, 72, 7); *(u32x4*)(kb_ + skey * 72 + 8 * sc8) = rk; \
        vt_[0] = (bf16_t)(rv.x & 0xffffu); vt_[72] = (bf16_t)(rv.x >> 16); vt_[144] = (bf16_t)(rv.y & 0xffffu); vt_[216] = (bf16_t)(rv.y >> 16); \
        vt_[288] = (bf16_t)(rv.z & 0xffffu); vt_[360] = (bf16_t)(rv.z >> 16); vt_[432] = (bf16_t)(rv.w & 0xffffu); vt_[504] = (bf16_t)(rv.w >> 16); } while (0)
    u32x4 rk, rv;
    if (mode != 3 && mode != 5) { float m = MINIT, l = 0.f; o[0] = Z16; o[1] = Z16; const int jmax = (t0 + 31) >> 6; const unsigned long long act = orm & (jmax >= 63 ? ~0ull : ((1ull << (jmax + 1)) - 1ull));
        if (act) { int j = __builtin_ctzll(act); unsigned long long rem = act & (act - 1ull); int buf = 0;
            TILE_LOAD(j, 1280, 1408); TILE_WRITE(0); int jn = rem ? __builtin_ctzll(rem) : -1; rem &= rem - 1ull; if (jn >= 0) TILE_LOAD(jn, 1280, 1408);
            LDS_BARRIER();
            for (;;) { const bf16_t* KB = (const bf16_t*)(F.lds + buf * 18432); const bf16_t* VB = KB + 64 * 72; const bool sel = (selm >> j) & 1ull; const bool allsel = __ballot(!sel) == 0ull;
                attn_tile64(KB, VB, qf, m, l, o, lane, allsel && (64 * j + 31 <= t0 + 4 * w), allsel && (64 * j + 63 <= t0 + 4 * w), [&](int ks, int kr) { return sel && (64 * j + 32 * ks + kr <= pos); });
                if (jn < 0) break;
                TILE_WRITE(buf ^ 1); j = jn; jn = rem ? __builtin_ctzll(rem) : -1; rem &= rem - 1ull; if (jn >= 0) TILE_LOAD(jn, 1280, 1408);
                LDS_BARRIER(); buf ^= 1; }
            LDS_BARRIER(); }
        l += __shfl_xor(l, 32); const float sc = l > 0.f ? gate[1] / l : 0.f; tot[0] = tot[0] + o[0] * sc; tot[1] = tot[1] + o[1] * sc; }
    if (mode != 3 && mode != 4) { float m = MINIT, l = 0.f; o[0] = Z16; o[1] = Z16; const int jlo = (t0 - (WINDOW - 1)) > 0 ? ((t0 - (WINDOW - 1)) >> 6) : 0, jmax = (t0 + 31) >> 6; int j = jlo, buf = 0;
        TILE_LOAD(j, 1536, 1664); TILE_WRITE(0); if (j < jmax) TILE_LOAD(j + 1, 1536, 1664);
        LDS_BARRIER();
        for (;;) { const bf16_t* KB = (const bf16_t*)(F.lds + buf * 18432); const bf16_t* VB = KB + 64 * 72;
            attn_tile64(KB, VB, qf, m, l, o, lane, (64 * j + 31 <= t0 + 4 * w) && (t0 + 4 * w + 3 - 64 * j < WINDOW), (64 * j + 63 <= t0 + 4 * w) && (t0 + 4 * w + 3 - (64 * j + 32) < WINDOW), [&](int ks, int kr) { const int rel = pos - (64 * j + 32 * ks + kr); return rel >= 0 && rel < WINDOW; });
            if (j >= jmax) break;
            TILE_WRITE(buf ^ 1); ++j; if (j < jmax) TILE_LOAD(j + 1, 1536, 1664);
            LDS_BARRIER(); buf ^= 1; }
        LDS_BARRIER();
        l += __shfl_xor(l, 32); const float sc = l > 0.f ? gate[2] / l : 0.f; tot[0] = tot[0] + o[0] * sc; tot[1] = tot[1] + o[1] * sc; }
#undef TILE_LOAD
#undef TILE_WRITE
    if (mode < 3) store_o(OUT + tok * DM + hd * 64, tot, hi);
}
struct PrivRegs { f32x4 k[8], v[8]; };
template <class RowF> __device__ __forceinline__ void priv_load(PrivRegs& R, int lane, RowF rowfn) {
    const int key = lane >> 1, half = lane & 1; const float* kf; const float* vf; const bf16_t* kb; const bf16_t* vb; rowfn(key, kf, vf, kb, vb);
#pragma unroll
    for (int q = 0; q < 8; ++q) { R.k[q] = (f32x4){0.f, 0.f, 0.f, 0.f}; R.v[q] = (f32x4){0.f, 0.f, 0.f, 0.f}; }
    if (kf) {
#pragma unroll
        for (int q = 0; q < 8; ++q) { R.k[q] = ((const f32x4*)(kf + 32 * half))[q]; R.v[q] = ((const f32x4*)(vf + 32 * half))[q]; } }
    else if (kb) {
#pragma unroll
        for (int q = 0; q < 4; ++q) { const u32x4 ka = ((const u32x4*)(kb + 32 * half))[q], va = ((const u32x4*)(vb + 32 * half))[q];
            R.k[2 * q] = (f32x4){bflo(ka.x), bfhi(ka.x), bflo(ka.y), bfhi(ka.y)}; R.k[2 * q + 1] = (f32x4){bflo(ka.z), bfhi(ka.z), bflo(ka.w), bfhi(ka.w)};
            R.v[2 * q] = (f32x4){bflo(va.x), bfhi(va.x), bflo(va.y), bfhi(va.y)}; R.v[2 * q + 1] = (f32x4){bflo(va.z), bfhi(va.z), bflo(va.w), bfhi(va.w)}; } }
}
__device__ __forceinline__ void priv_write(const PrivRegs& R, bf16_t* PK, bf16_t* PV, int lane) {
    const int key = lane >> 1, half = lane & 1, pc = vperm(key);
#pragma unroll
    for (int q = 0; q < 4; ++q) { const f32x4 a = R.k[2 * q], a2 = R.k[2 * q + 1], c = R.v[2 * q], c2 = R.v[2 * q + 1];
        u32x4 w; w.x = pk2(a.x, a.y); w.y = pk2(a.z, a.w); w.z = pk2(a2.x, a2.y); w.w = pk2(a2.z, a2.w); *(u32x4*)(PK + key * PKP + 32 * half + 8 * q) = w;
        bf16_t* pv = PV + vtoff(32 * half + 8 * q, pc, PVP, 3); const unsigned c01 = pk2(c.x, c.y), c23 = pk2(c.z, c.w), c45 = pk2(c2.x, c2.y), c67 = pk2(c2.z, c2.w);
        pv[0] = (bf16_t)(c01 & 0xffffu); pv[PVP] = (bf16_t)(c01 >> 16); pv[2 * PVP] = (bf16_t)(c23 & 0xffffu); pv[3 * PVP] = (bf16_t)(c23 >> 16);
        pv[4 * PVP] = (bf16_t)(c45 & 0xffffu); pv[5 * PVP] = (bf16_t)(c45 >> 16); pv[6 * PVP] = (bf16_t)(c67 & 0xffffu); pv[7 * PVP] = (bf16_t)(c67 >> 16); }
}
__device__ __forceinline__ void merge_branch(Frame& F, float m, float l, const f32x16 (&o)[2], int gate_idx) {
    float* MB = (float*)(F.lds + A_PRIV); float* TOT = (float*)(F.lds + A_TOT); const float* GT = (const float*)(F.lds + A_GT);
    const int lane = F.lane, w = F.wave, r = lane & 31, hi = lane >> 5;
    LDS_BARRIER();
    { float* mb = MB + (w * 32 + r) * 66;
#pragma unroll
        for (int dt = 0; dt < 2; ++dt)
#pragma unroll
            for (int i = 0; i < 16; ++i) mb[32 * dt + crow(i, hi)] = o[dt][i];
        const float lt = l + __shfl_xor(l, 32); if (hi == 0) { mb[64] = m; mb[65] = lt; } }
    LDS_BARRIER();
    for (int e = F.tid; e < 32 * 64; e += NT) { const int q = e >> 6, d = e & 63; float M = NEGB;
#pragma unroll
        for (int ww = 0; ww < 8; ++ww) M = fmaxf(M, MB[(ww * 32 + q) * 66 + 64]);
        float L = 0.f, O = 0.f;
#pragma unroll
        for (int ww = 0; ww < 8; ++ww) { const float* mb = MB + (ww * 32 + q) * 66; const float sc = EXP2F(mb[64] - M); L += mb[65] * sc; O += mb[d] * sc; }
        if (L > 0.f) TOT[q * 64 + d] += GT[q * 4 + gate_idx] * O / L; }
    LDS_BARRIER();
}
__device__ __forceinline__ void attn_sample_unit(Frame& F, int li, int b, int g) { UNIT_BEGIN(F);
    const bf16_t* PROJ = WSP(bf16_t, WS_PROJ); const bf16_t* KC = WSP(bf16_t, WS_KC); bf16_t* OUT = WSP(bf16_t, WS_YMIX);
    const unsigned* SM = (const unsigned*)(F.lds + A_SM); float* TOT = (float*)(F.lds + A_TOT); float* GT = (float*)(F.lds + A_GT);
    const int lane = F.lane, w = F.wave, r = lane & 31, hi = lane >> 5, tl = r >> 3, pos = PAST + tl, hd = g * 8 + (r & 7); const size_t tok = (size_t)MP + b * DEC_SEQ + tl;
    bf16x8 qf[4];
#pragma unroll
    for (int ks = 0; ks < 4; ++ks) qf[ks] = *(const bf16x8*)(PROJ + tok * IN_ODD_PAD + hd * 64 + 16 * ks + 8 * hi);
    scale_q(qf);
    LDS_BARRIER();
    if (w == 0 && hi == 0) {
#pragma unroll
        for (int q = 0; q < 3; ++q) GT[r * 4 + q] = sigmoidf_(bf2f(PROJ[tok * IN_ODD_PAD + 1792 + hd * 3 + q])); }
    stage_kv_bf16(F, 128, [&](int key, const bf16_t*& kp, const bf16_t*& vp) { if (key < NCMP_S) { kp = KC + (((size_t)0 * (BATCH + DEC_BATCH) + BATCH + b) * 128 + key) * 128 + g * 64; vp = KC + (((size_t)1 * (BATCH + DEC_BATCH) + BATCH + b) * 128 + key) * 128 + g * 64; } else { kp = nullptr; vp = nullptr; } });
    LDS_BARRIER();
    f32x16 o[2];
    attn_cmp(F, qf, pos, NCMP_S, tl, NCMP_S - 1, o);
    if (w == 0) {
#pragma unroll
        for (int dt = 0; dt < 2; ++dt)
#pragma unroll
            for (int i = 0; i < 16; ++i) TOT[r * 64 + 32 * dt + crow(i, hi)] = o[dt][i] * GT[r * 4 + 0]; }
    LDS_BARRIER();
    attn_topk(F, DEC_SEQ, PAST, NCMP_S, NSLC_S);
    const unsigned long long selm = (unsigned long long)SM[tl * 2] | ((unsigned long long)SM[tl * 2 + 1] << 32), orm = (unsigned long long)SM[64] | ((unsigned long long)SM[65] << 32);
    bf16_t* PK = (bf16_t*)(F.lds + A_PRIV + w * PRIV_BYTES); bf16_t* PV = PK + 32 * PKP;
    const int* PT = (const int*)F.in[I_PT] + b * NPAGES;
    PrivRegs R;
    { float m = MINIT, l = 0.f; o[0] = Z16; o[1] = Z16;
        auto selrow = [&](int k0) { return [&, k0](int key, const float*& kf, const float*& vf, const bf16_t*& kb, const bf16_t*& vb) { const int row = k0 + key; kf = nullptr; vf = nullptr; kb = nullptr; vb = nullptr;
                if (row < PAST) { const float* base = F.in[I_CSEL] + (((size_t)li * NPOOL + PT[row >> 7]) * PAGE + (row & 127)) * 256 + g * 64; kf = base; vf = base + 128; }
                else if (row < PAST + DEC_SEQ) { const bf16_t* base = PROJ + ((size_t)MP + b * DEC_SEQ + (row - PAST)) * IN_ODD_PAD + 1280 + g * 64; kb = base; vb = base + 128; } }; };
        int sidx = w; while (sidx < 2 * NSLC_S && !((orm >> (sidx >> 1)) & 1ull)) sidx += 8;
        if (sidx < 2 * NSLC_S) { priv_load(R, lane, selrow(32 * sidx)); priv_write(R, PK, PV, lane); WAVE_SYNC(); }
        while (sidx < 2 * NSLC_S) { int nx = sidx + 8; while (nx < 2 * NSLC_S && !((orm >> (nx >> 1)) & 1ull)) nx += 8;
            if (nx < 2 * NSLC_S) priv_load(R, lane, selrow(32 * nx));
            const int j = sidx >> 1, k0 = 32 * sidx; const bool sel = (selm >> j) & 1ull;
            attn_sub32(PK, PKP, PV, PVP, 0, 3, qf, m, l, o, lane, false, [&](int kr) { return sel && (k0 + kr <= pos); });
            WAVE_SYNC();
            if (nx < 2 * NSLC_S) { priv_write(R, PK, PV, lane); WAVE_SYNC(); }
            sidx = nx; }
        merge_branch(F, m, l, o, 1); }
    { float m = MINIT, l = 0.f; o[0] = Z16; o[1] = Z16; constexpr int NSUBW = (WBUF + DEC_SEQ + 31) / 32;
        auto winrow = [&](int k0) { return [&, k0](int key, const float*& kf, const float*& vf, const bf16_t*& kb, const bf16_t*& vb) { const int row = k0 + key; kf = nullptr; vf = nullptr; kb = nullptr; vb = nullptr;
                if (row < WBUF) { const float* base = F.in[I_WINST] + (((size_t)li * DEC_BATCH + b) * WBUF + row) * 256 + g * 64; kf = base; vf = base + 128; }
                else if (row < WBUF + DEC_SEQ) { const bf16_t* base = PROJ + ((size_t)MP + b * DEC_SEQ + (row - WBUF)) * IN_ODD_PAD + 1536 + g * 64; kb = base; vb = base + 128; } }; };
        int sidx = w;
        if (sidx < NSUBW) { priv_load(R, lane, winrow(32 * sidx)); priv_write(R, PK, PV, lane); WAVE_SYNC(); }
        while (sidx < NSUBW) { const int nx = sidx + 8;
            if (nx < NSUBW) priv_load(R, lane, winrow(32 * nx));
            const int k0 = 32 * sidx;
            attn_sub32(PK, PKP, PV, PVP, 0, 3, qf, m, l, o, lane, false, [&](int kr) { const int rel = (WBUF + tl) - (k0 + kr); return rel >= 0 && rel < WINDOW && (k0 + kr) < WBUF + DEC_SEQ; });
            WAVE_SYNC();
            if (nx < NSUBW) { priv_write(R, PK, PV, lane); WAVE_SYNC(); }
            sidx = nx; }
        merge_branch(F, m, l, o, 2); }
    for (int e = F.tid; e < 32 * 64; e += NT) { const int q = e >> 6, d = e & 63; OUT[((size_t)MP + b * DEC_SEQ + (q >> 3)) * DM + (g * 8 + (q & 7)) * 64 + d] = (bf16_t)f2bf(TOT[e]); }
}
__device__ NOINLINE void ph_attn(Frame F, int li, int only) { frame_refresh(F);
    constexpr int NP = BATCH * 2 * (SEQ / 32), NS = DEC_BATCH * 2;
    if (only != 2) for (int u = F.bid; u < NP; u += F.G) { constexpr int NQ = SEQ / 32, QR = NQ / 4; const int idx = u / (BATCH * 2), bg = u % (BATCH * 2), rr = idx / QR, k = idx % QR;
        const int qt = (NQ % 4 == 0 && NP == 4 * F.G) ? (rr == 0 ? NQ - 1 - k : rr == 1 ? NQ / 2 + k : rr == 2 ? NQ / 2 - 1 - k : k) : (NQ - 1) - idx;
        attn_prompt_unit(F, li, bg >> 1, bg & 1, qt, only); }
    frame_refresh(F);
    if (only == 0 || only == 2) for (int v = F.bid; v < NS; v += F.G) attn_sample_unit(F, li, v >> 1, v & 1);
}
#ifndef CPU_EMU
#define XB_TMO      128
#define XB_XCNT(j)  (256  + 64 * (j))
#define XB_XSUB(j)  (1280 + 64 * (j))
#define XB_XGEN(j)  (2304 + 64 * (j))
#define XB_TOP      3328
#define XB_TOPGEN   3392
#define XCD_BAR_WORDS 3456
#define XB_SPIN_CAP (1u << 22)
__device__ __forceinline__ unsigned xb_ld(unsigned* p)              { return __hip_atomic_load(p, __ATOMIC_RELAXED, __HIP_MEMORY_SCOPE_AGENT); }
__device__ __forceinline__ unsigned xb_add(unsigned* p, unsigned v) { return __hip_atomic_fetch_add(p, v, __ATOMIC_RELAXED, __HIP_MEMORY_SCOPE_AGENT); }
__device__ __forceinline__ unsigned xb_xcc_id() { return (unsigned)__builtin_amdgcn_s_getreg((3 << 11) | 20) & 0xFu; }
#define XB_SPIN(cond, bar) do { unsigned _sp = 0; while (cond) { __builtin_amdgcn_s_sleep(1); \
    if ((++_sp & 255u) == 0u) { if (xb_ld(&(bar)[XB_TMO])) break; if (_sp > XB_SPIN_CAP) { atomicAdd(&(bar)[XB_TMO], 1u); break; } } } } while (0)
struct XcdBarrier { unsigned* bar; unsigned x; volatile LAS unsigned* st; };
__device__ __forceinline__ XcdBarrier xcd_barrier_post(unsigned* bar, volatile LAS unsigned* st) {
    XcdBarrier b; b.bar = bar; b.x = xb_xcc_id(); b.st = st;
    if (threadIdx.x == 0) (void)xb_add(&bar[XB_XCNT(b.x)], 1u);
    return b;
}
__device__ __forceinline__ void xcd_barrier_complete(unsigned* bar, unsigned x, unsigned& nloc, unsigned& nx) {
    const unsigned G = gridDim.x * gridDim.y * gridDim.z;
    unsigned sum, cnt, mine, sp = 0u;
    for (;;) {
        sum = 0u; cnt = 0u; mine = 0u;
#pragma unroll
        for (unsigned j = 0; j < 16; ++j) { const unsigned c = xb_ld(&bar[XB_XCNT(j)]); sum += c; cnt += (c > 0u) ? 1u : 0u; mine = (j == x) ? c : mine; }
        if (sum == G) break;
        __builtin_amdgcn_s_sleep(1);
        if ((++sp & 255u) == 0u) { if (xb_ld(&bar[XB_TMO])) break; if (sp > XB_SPIN_CAP) { atomicAdd(&bar[XB_TMO], 1u); break; } }
    }
    nloc = mine > 0u ? mine : 1u; nx = cnt > 0u ? cnt : 1u;
}
__device__ __forceinline__ void xcd_barrier(const XcdBarrier& b) {
    asm volatile("s_waitcnt vmcnt(0)" ::: "memory");
    __syncthreads();
    if (threadIdx.x == 0) {
        unsigned* bar = b.bar;
        __builtin_amdgcn_s_waitcnt(0);
        unsigned nloc = b.st[0], nx = b.st[1];
        if (nloc == 0u) { xcd_barrier_complete(bar, b.x, nloc, nx); b.st[0] = nloc; b.st[1] = nx; }
        const unsigned old = xb_add(&bar[XB_XSUB(b.x)], 1u);
        const unsigned gen = old / nloc;
        if (old + 1u == (gen + 1u) * nloc) {
            __builtin_amdgcn_fence(__ATOMIC_RELEASE, "agent");
            asm volatile("s_waitcnt vmcnt(0)" ::: "memory");
            const unsigned og = xb_add(&bar[XB_TOP], 1u);
            const unsigned tg = og / nx;
            if (og + 1u == (tg + 1u) * nx) xb_add(&bar[XB_TOPGEN], 1u);
            else XB_SPIN(xb_ld(&bar[XB_TOPGEN]) == tg, bar);
            __builtin_amdgcn_fence(__ATOMIC_ACQUIRE, "agent");
            xb_add(&bar[XB_XGEN(b.x)], 1u);
            asm volatile("s_waitcnt vmcnt(0)" ::: "memory");
        } else {
            XB_SPIN(xb_ld(&bar[XB_XGEN(b.x)]) == gen, bar);
            __builtin_amdgcn_fence(__ATOMIC_ACQUIRE, "agent");
            asm volatile("s_waitcnt vmcnt(0)" ::: "memory");
        }
    }
    __syncthreads();
}
#endif
constexpr int PH_PER_LAYER = 12, PH_END = 1 + DEPTH * PH_PER_LAYER;
__host__ __device__ inline bool phase_used(int id) {
    if (id == 0) return true;
    const int l = (id - 1) / PH_PER_LAYER, k = (id - 1) % PH_PER_LAYER;
    if (l >= DEPTH) return false;
    if ((l % 2 == 0) ? (k == 5 || k > 8) : (k == 3 || k == 6 || k > 9)) return false;
    if ((l % 2 == 0) ? (k == 8) : (k == 9)) return l == DEPTH - 1;
    return true;
}
constexpr int LAST_PHASE = 1 + (DEPTH - 1) * PH_PER_LAYER + ((DEPTH - 1) % 2 == 0 ? 8 : 9);

__global__ void __launch_bounds__(NT, 2) fwd(Args args) {
#ifdef CPU_EMU
    unsigned char* lds = (unsigned char*)emu::W->lds;
#else
    extern __shared__ __attribute__((aligned(16))) unsigned char lds[];
#endif
    Frame F; F.lds = (unsigned char*)lds; F.tid = threadIdx.x; F.lane = F.tid & 63; F.wave = RFL(F.tid >> 6); F.G = gridDim.x; F.bid = blockIdx.x;
    F.gw = F.bid * NWAVE + F.wave; F.NGW = F.G * NWAVE; F.out = args.out; F.ws = args.ws; F.in = args.in;
    const int lo = args.ph_lo, hi = args.ph_hi; const bool dup = args.dup != 0; const int only = args.dup >> 1;
#ifndef CPU_EMU
    const bool one_launch = (hi - lo) > 1;
    if (F.tid < 64) ((unsigned*)(lds + LDS_MISC))[F.tid] = 0u;
    __syncthreads();
    XcdBarrier bar; bar.bar = (unsigned*)(args.ws + WS_CTL) + 4096; bar.x = 0; bar.st = nullptr;
    if (one_launch) bar = xcd_barrier_post((unsigned*)(args.ws + WS_CTL) + 4096, (volatile LAS unsigned*)(lds + LDS_MISC));
#define SEAM(id) do { if (one_launch && (id) != LAST_PHASE) xcd_barrier(bar); } while (0)
#else
#define SEAM(id) do { } while (0)
#endif
#define IN(id) (lo <= (id) && (id) < hi && phase_used(id))
#define XN WSP(bf16_t, WS_XN)
#define SSQ WSP(float, WS_SSQ)
#define XBW (dup ? (bf16_t*)nullptr : XN)
#define SSQW (dup ? (float*)nullptr : SSQ)
#define X (dup ? WSP(float, WS_DUMMY) : WSP(float, WS_X))
#define H WSP(bf16_t, WS_H)
#define PROJ WSP(bf16_t, WS_PROJ)
#define YMIX WSP(bf16_t, WS_YMIX)
    if (IN(0)) { ph_prologue(F, only); SEAM(0); }
#pragma unroll
    for (int l = 0; l < DEPTH; ++l) {
        const int pb = 1 + l * PH_PER_LAYER, li = l >> 1;
        int k0;
        if ((l & 1) == 0) {
            if (IN(pb + 0)) { if (only != 2) pg8::gemm_call(XN, WSP(bf16_t, WS_WINE) + (size_t)li * IN_EVEN_PAD * DM, MT, IN_EVEN_PAD, DM, pg8::EpiBf16<0>{PROJ, IN_EVEN_PAD, SSQ, nullptr}, (int)gridDim.x, (int)blockIdx.x);
                SEAM(pb + 0); }
            if (IN(pb + 1)) { ph_even_local(F, li, only); SEAM(pb + 1); }
            if (IN(pb + 2)) { ph_ssd_carry(F, li); SEAM(pb + 2); }
            if (IN(pb + 3)) { ph_ssd_fix(F, li); SEAM(pb + 3); }
            if (IN(pb + 4)) { if (only != 2) pg8::gemm_call(YMIX, WSP(bf16_t, WS_WOUTE) + (size_t)li * DM * MIXE, MP, DM, MIXE, pg8::EpiResid{X, DM, XBW, SSQW}, (int)gridDim.x, (int)blockIdx.x);
                if (only != 1) ph_gemm_small(F, 2, YMIX + (size_t)MP * MIXE, WSP(bf16_t, WS_WOUTE) + (size_t)li * DM * MIXE, DM, MIXE, X + (size_t)MP * DM, DM, dup ? (bf16_t*)nullptr : XN + (size_t)MP * DM, dup ? (float*)nullptr : SSQ + (size_t)MP * 32); SEAM(pb + 4); }
            k0 = 5;
        } else {
            if (IN(pb + 0)) { if (only != 2) pg8::gemm_call(XN, WSP(bf16_t, WS_WINO) + (size_t)li * IN_ODD_PAD * DM, MP, IN_ODD_PAD, DM, pg8::EpiBf16<0>{PROJ, IN_ODD_PAD, SSQ, nullptr}, (int)gridDim.x, (int)blockIdx.x);
                if (only != 1) ph_gemm_small(F, 0, XN + (size_t)MP * DM, WSP(bf16_t, WS_WINO) + (size_t)li * IN_ODD_PAD * DM, IN_ODD_PAD, DM, PROJ + (size_t)MP * IN_ODD_PAD, IN_ODD_PAD, nullptr, SSQ + (size_t)MP * 32); SEAM(pb + 0); }
            if (IN(pb + 1)) { ph_odd_rope(F, li, dup, only); SEAM(pb + 1); }
            if (IN(pb + 2)) { for (int kv = 0; kv < 2; ++kv) pg8::gemm_call(WSP(bf16_t, WS_CMPA) + (size_t)kv * CMPROWS_PAD * 1024, WSP(bf16_t, WS_CW1) + (size_t)(li * 2 + kv) * 256 * 1024, CMPROWS_PAD, 256, 1024,
                    pg8::EpiCmp{WSP(bf16_t, WS_KC), WSP(bf16_t, WS_CW2T) + (size_t)(li * 2 + kv) * 64 * 128, WSP(float, WS_CBIAS) + (size_t)(li * 2 + kv) * 32 * 128, kv}, (int)gridDim.x, (int)blockIdx.x);
                if ((int)blockIdx.x >= CMPROWS_PAD / 256) ph_win_copy(F, li, (int)blockIdx.x - CMPROWS_PAD / 256, (int)gridDim.x - CMPROWS_PAD / 256);
                else if ((int)gridDim.x <= CMPROWS_PAD / 256) ph_win_copy(F, li, (int)blockIdx.x, (int)gridDim.x);
                SEAM(pb + 2); }
            if (IN(pb + 4)) { ph_attn(F, li, only); SEAM(pb + 4); }
            if (IN(pb + 5)) { if (only != 2) pg8::gemm_call(YMIX, WSP(bf16_t, WS_WOUTO) + (size_t)li * DM * DM, MP, DM, DM, pg8::EpiResid{X, DM, XBW, SSQW}, (int)gridDim.x, (int)blockIdx.x);
                if (only != 1) ph_gemm_small(F, 2, YMIX + (size_t)MP * DM, WSP(bf16_t, WS_WOUTO) + (size_t)li * DM * DM, DM, DM, X + (size_t)MP * DM, DM, dup ? (bf16_t*)nullptr : XN + (size_t)MP * DM, dup ? (float*)nullptr : SSQ + (size_t)MP * 32); SEAM(pb + 5); }
            k0 = 6;
        }
        if (IN(pb + k0 + 1)) { if (only != 2) pg8::gemm_call(XN, WSP(bf16_t, WS_WUP) + (size_t)l * DFF * DM, MP, DFF, DM, pg8::EpiBf16<1>{H, DFF, SSQ, nullptr}, (int)gridDim.x, (int)blockIdx.x);
            if (only != 1) ph_gemm_small(F, 1, XN + (size_t)MP * DM, WSP(bf16_t, WS_WUP) + (size_t)l * DFF * DM, DFF, DM, H + (size_t)MP * DFF, DFF, nullptr, SSQ + (size_t)MP * 32); SEAM(pb + k0 + 1); }
        if (IN(pb + k0 + 2)) { if (only != 2) pg8::gemm_call(H, WSP(bf16_t, WS_WDN) + (size_t)l * DM * DFF, MP, DM, DFF, pg8::EpiResid{X, DM, XBW, SSQW}, (int)gridDim.x, (int)blockIdx.x);
            if (only != 1) ph_gemm_small(F, 2, H + (size_t)MP * DFF, WSP(bf16_t, WS_WDN) + (size_t)l * DM * DFF, DM, DFF, X + (size_t)MP * DM, DM, dup ? (bf16_t*)nullptr : XN + (size_t)MP * DM, dup ? (float*)nullptr : SSQ + (size_t)MP * 32); SEAM(pb + k0 + 2); }
        if (IN(pb + k0 + 3)) { ph_norm(F, F.in[I_NFIN], true); SEAM(pb + k0 + 3); }
    }
}

#undef XN
#undef SSQ
#undef XBW
#undef SSQW
#undef X
#undef H
#undef PROJ
#undef YMIX
#ifndef PROBE_REP_MASK
#define PROBE_REP_MASK 0
#define PROBE_REP_N 1
#endif
#ifndef PROBE_SUB
#define PROBE_SUB 0
#endif
static int phase_class(int id) { if (id == 0) return 0; const int l = (id - 1) / PH_PER_LAYER, k = (id - 1) % PH_PER_LAYER;
    if ((l & 1) == 0) { const int m[9] = {1, 2, 3, 4, 5, 6, 7, 8, 6}; return m[k]; } else { const int m[10] = {1, 9, 10, 11, 12, 5, 6, 7, 8, 6}; return m[k]; } }
#ifndef ONE_LAUNCH
#define ONE_LAUNCH 0
#endif
extern "C" void kernel_launch(void* const* d_in, const int* in_sizes, int n_in, void* d_out, int out_size, void* d_ws, size_t ws_size, hipStream_t stream) {
    static int grid = 0;
    if (grid == 0) {
        if (n_in != N_IN || (size_t)out_size != O_END || ws_size < WS_END) { fprintf(stderr, "kernel_launch: shape mismatch n_in %d out %d (want %zu) ws %zu (want %zu)\n", n_in, out_size, (size_t)O_END, ws_size, (size_t)WS_END); grid = -1; return; }
#ifdef CPU_EMU
        grid = 32;
#else
        int dev = 0, cus = 0, per_cu = 0;
        if (hipGetDevice(&dev) != hipSuccess || hipDeviceGetAttribute(&cus, hipDeviceAttributeMultiprocessorCount, dev) != hipSuccess) { grid = -1; return; }
        if (hipFuncSetAttribute((const void*)fwd, hipFuncAttributeMaxDynamicSharedMemorySize, LDS_BYTES) != hipSuccess) { fprintf(stderr, "kernel_launch: hipFuncSetAttribute failed\n"); grid = -1; return; }
        if (hipOccupancyMaxActiveBlocksPerMultiprocessor(&per_cu, (const void*)fwd, NT, LDS_BYTES) != hipSuccess || per_cu < 1) fprintf(stderr, "kernel_launch: occupancy query says %d\n", per_cu);
        (void)hipGetLastError();
        if (cus < CMPROWS_PAD / 256) { fprintf(stderr, "kernel_launch: needs >= %d CUs\n", CMPROWS_PAD / 256); grid = -1; return; }
        grid = cus;
#endif
    }
    if (grid < 0) return;
    Args a{}; a.dup = 0; a.pad = 0;
    for (int i = 0; i < N_IN; ++i) a.in[i] = (const float*)d_in[i];
    a.out = (float*)d_out; a.ws = (unsigned char*)d_ws;
#ifdef CPU_EMU
    for (int id = 0; id < PH_END; ++id) if (phase_used(id)) { a.ph_lo = id; a.ph_hi = id + 1; emu::launch(dim3(grid), dim3(NT), LDS_BYTES, [=]() { fwd(a); }); emu_after_phase(id, a); }
#else
    (void)hipMemsetAsync((char*)d_ws + WS_CTL, 0, CTL_BYTES, stream);
    if (ONE_LAUNCH) { a.ph_lo = 0; a.ph_hi = PH_END; hipLaunchKernelGGL(fwd, dim3(grid), dim3(NT), LDS_BYTES, stream, a); }
    else for (int id = 0; id < PH_END; ++id) if (phase_used(id)) { a.ph_lo = id; a.ph_hi = id + 1; a.dup = 0; hipLaunchKernelGGL(fwd, dim3(grid), dim3(NT), LDS_BYTES, stream, a);
        if ((PROBE_REP_MASK >> phase_class(id)) & 1) for (int r = 0; r < PROBE_REP_N; ++r) { a.dup = 1 + 2 * PROBE_SUB; hipLaunchKernelGGL(fwd, dim3(grid), dim3(NT), LDS_BYTES, stream, a); } }
#endif
}
```

```cpp
#define ONE_LAUNCH 1
#ifdef CPU_EMU
#include "emu.h"
#else
#include <hip/hip_runtime.h>
#endif
#include <cstdio>
#include <cstdint>
#include <cmath>

#ifndef CFG_BATCH
#define CFG_BATCH 8
#define CFG_SEQ 2048
#define CFG_DEPTH 4
#define CFG_DEC_BATCH 128
#define CFG_PAST 2048
#define CFG_DFF 4096
#define CFG_TOPK 16
#define CFG_WINDOW 512
#endif
constexpr int DM = 1024, BATCH = CFG_BATCH, SEQ = CFG_SEQ, DEPTH = CFG_DEPTH, DEC_BATCH = CFG_DEC_BATCH, DEC_SEQ = 4, PAST = CFG_PAST, PAGE = 128;
constexpr int N_SSM = (DEPTH + 1) / 2, N_ATT = DEPTH / 2, DFF = CFG_DFF, TOPK = CFG_TOPK, WINDOW = CFG_WINDOW;
constexpr int MP = BATCH * SEQ, MS = DEC_BATCH * DEC_SEQ, MT = MP + MS;
constexpr int S5W = 512, S5G = 32, S5P = 64;
constexpr int SSDH = 16, SSDP = 64, SSDN = 128, SSDG = 4, CONVD = 2048, CHUNK = 128, NCH = SEQ / CHUNK;
constexpr int IN_EVEN = 3600, IN_EVEN_PAD = 3840, IN_ODD = 1840, IN_ODD_PAD = 2048, MIXE = 1536;
constexpr int NPAGES = PAST / PAGE, NPOOL = DEC_BATCH * NPAGES * 5 / 4, WBUF = (WINDOW < PAST ? WINDOW : PAST);
constexpr int WKEEP_P = (WINDOW < SEQ ? WINDOW : SEQ), WKEEP_S = (WINDOW < WBUF + DEC_SEQ ? WINDOW : WBUF + DEC_SEQ);
constexpr int NCHK_P = SEQ / 16, NCHK_S = PAST / 16, NCMP_P = NCHK_P - 1, NCMP_S = (PAST + DEC_SEQ) / 16 - 1;
static_assert((PAST + DEC_SEQ) / 16 == NCHK_S, "sample compression covers the past rows only");
constexpr int NSLC_P = (SEQ + 63) / 64, NSLC_S = (PAST + DEC_SEQ + 63) / 64;
constexpr int CMPROWS = BATCH * NCHK_P * 2 + DEC_BATCH * NCHK_S * 2, CMPROWS_PAD = (CMPROWS + 255) / 256 * 256;
static_assert(MP % 256 == 0 && MS % 64 == 0 && SEQ % CHUNK == 0 && NSLC_P <= 64 && NSLC_S <= 64 && NCMP_P <= 128 && NCMP_S <= 128, "tiling");
constexpr int NROPE = (SEQ > PAST + DEC_SEQ ? SEQ : PAST + DEC_SEQ);
constexpr float EPS = 1e-5f;
enum { I_XP = 0, I_XS, I_S5ST, I_SSDST, I_CONVST, I_CCMP, I_CSEL, I_WINST, I_PT, I_NME, I_WINE, I_S5ARE, I_S5AIM, I_S5LDT, I_S5BRE, I_S5BIM, I_S5CRE, I_S5CIM,
       I_S5D, I_GLUW, I_GLUB, I_CONVW, I_CONVB, I_DTB, I_ALOG, I_SSDD, I_SSDNORM, I_WOUTE, I_NMO, I_WINO, I_CW1, I_CW2, I_CPOS, I_WOUTO, I_NMLP, I_WUP, I_WDN, I_NFIN, N_IN };
constexpr size_t O_YP = 0, O_YS = O_YP + (size_t)MP * DM, O_S5P = O_YS + (size_t)MS * DM, O_S5S = O_S5P + (size_t)N_SSM * BATCH * 4096, O_SSDP = O_S5S + (size_t)N_SSM * DEC_BATCH * 4096,
    O_SSDS = O_SSDP + (size_t)N_SSM * BATCH * 131072, O_CONVP = O_SSDS + (size_t)N_SSM * DEC_BATCH * 131072, O_CONVS = O_CONVP + (size_t)N_SSM * BATCH * 3 * CONVD,
    O_CMPP = O_CONVS + (size_t)N_SSM * DEC_BATCH * 3 * CONVD, O_CMPS = O_CMPP + (size_t)N_ATT * MP * 256, O_SELP = O_CMPS + (size_t)N_ATT * MS * 256, O_SELS = O_SELP + (size_t)N_ATT * MP * 256,
    O_WINP = O_SELS + (size_t)N_ATT * MS * 256, O_WINS = O_WINP + (size_t)N_ATT * BATCH * WKEEP_P * 256, O_END = O_WINS + (size_t)N_ATT * DEC_BATCH * WKEEP_S * 256;
constexpr size_t al(size_t x) { return (x + 4095) / 4096 * 4096; }
constexpr size_t WS_CTL = 0, CTL_BYTES = 1u << 20, WS_TAB = CTL_BYTES - 4096;
constexpr size_t WS_WINE = WS_CTL + CTL_BYTES, WS_WOUTE = WS_WINE + al((size_t)N_SSM * IN_EVEN_PAD * DM * 2), WS_WINO = WS_WOUTE + al((size_t)N_SSM * DM * MIXE * 2),
    WS_WOUTO = WS_WINO + al((size_t)N_ATT * IN_ODD_PAD * DM * 2), WS_WUP = WS_WOUTO + al((size_t)N_ATT * DM * DM * 2), WS_WDN = WS_WUP + al((size_t)DEPTH * DFF * DM * 2),
    WS_CW1 = WS_WDN + al((size_t)DEPTH * DM * DFF * 2), WS_CBIAS = WS_CW1 + al((size_t)N_ATT * 2 * 256 * 1024 * 2), WS_S5A = WS_CBIAS + al((size_t)N_ATT * 2 * 32 * 128 * 4),
    WS_S5B = WS_S5A + al((size_t)N_SSM * S5G * S5P * 2 * 4), WS_S5C = WS_S5B + al((size_t)N_SSM * S5G * 128 * 16 * 2), WS_X = WS_S5C + al((size_t)N_SSM * S5G * 16 * 128 * 2),
    WS_XN = WS_X + al((size_t)MT * DM * 4), WS_PROJ = WS_XN + al((size_t)MT * DM * 2), WS_H = WS_PROJ + al((size_t)MT * IN_EVEN_PAD * 2), WS_YMIX = WS_H + al((size_t)MT * DFF * 2),
    WS_XBCA = WS_YMIX + al((size_t)MT * MIXE * 2), WS_DTV = WS_XBCA + al((size_t)MT * CONVD * 2), WS_ACS = WS_DTV + al((size_t)MT * 16 * 4), WS_YD = WS_ACS + al((size_t)MT * 16 * 4),
    WS_STL = WS_YD + al((size_t)MT * DM * 4), WS_STIN = WS_STL + al((size_t)BATCH * NCH * SSDH * 8192 * 4), WS_CMPA = WS_STIN + al((size_t)BATCH * NCH * SSDH * 8192 * 2),
    WS_CMPAB = WS_CMPA + al((size_t)2 * CMPROWS_PAD * 1024 * 2), WS_KC = WS_CMPAB + al((size_t)2 * CMPROWS_PAD * 256 * 2), WS_DUMMY = WS_KC + al((size_t)2 * (BATCH + DEC_BATCH) * 128 * 128 * 2), WS_SSQ = WS_DUMMY + al((size_t)MT * DM * 4), WS_CW2T = WS_SSQ + al((size_t)MT * 32 * 4), WS_ROPE = WS_CW2T + al((size_t)N_ATT * 2 * 64 * 128 * 2), WS_END = WS_ROPE + al((size_t)NROPE * 16 * 4);

#ifdef CPU_EMU
#define LAS
#define WAIT_VM(n)
#define WAIT_LGKM(n)
#define S_BARRIER() emu::block_barrier()
#define SCHED_BARRIER()
#define SETPRIO(x)
#define WAVE_SYNC() emu::wave_sync()
#define RFL(x) (x)
#define LDS_BARRIER() emu::block_barrier()
#define GLDS16(g, l) emu_glds16((const void*)(g), (void*)(l))
#define MFMA16(a, b, c) emu_mfma16(a, b, c)
#define MFMA32(a, b, c) emu_mfma32(a, b, c)
#define EXP2F(x) exp2f(x)
#define RCPF(x) (1.0f / (x))
#else
#define LAS __attribute__((address_space(3)))
#define WAIT_VM(n) asm volatile("s_waitcnt vmcnt(" #n ")" ::: "memory")
#define WAIT_LGKM(n) asm volatile("s_waitcnt lgkmcnt(" #n ")" ::: "memory")
#define S_BARRIER() __builtin_amdgcn_s_barrier()
#define SCHED_BARRIER() __builtin_amdgcn_sched_barrier(0)
#define SETPRIO(x) __builtin_amdgcn_s_setprio(x)
#define WAVE_SYNC() do { asm volatile("s_waitcnt lgkmcnt(0)" ::: "memory"); __builtin_amdgcn_wave_barrier(); } while (0)
#define RFL(x) __builtin_amdgcn_readfirstlane(x)
#define LDS_BARRIER() do { asm volatile("s_waitcnt lgkmcnt(0)" ::: "memory"); __builtin_amdgcn_s_barrier(); asm volatile("" ::: "memory"); } while (0)
#define GLDS16(g, l) __builtin_amdgcn_global_load_lds((const unsigned*)(g), (LAS unsigned*)(l), 16, 0, 0)
#define MFMA16(a, b, c) __builtin_amdgcn_mfma_f32_16x16x32_bf16(a, b, c, 0, 0, 0)
#define MFMA32(a, b, c) __builtin_amdgcn_mfma_f32_32x32x16_bf16(a, b, c, 0, 0, 0)
#define EXP2F(x) __builtin_amdgcn_exp2f(x)
#define RCPF(x) __builtin_amdgcn_rcpf(x)
#endif

typedef unsigned short bf16_t;
typedef short bf16x8 __attribute__((ext_vector_type(8)));
typedef float f32x4 __attribute__((ext_vector_type(4)));
typedef float f32x16 __attribute__((ext_vector_type(16)));
typedef unsigned u32x4 __attribute__((ext_vector_type(4)));
typedef unsigned u32x2 __attribute__((ext_vector_type(2)));
typedef float f32x2 __attribute__((ext_vector_type(2)));
constexpr int NT = 512, NWAVE = 8;
constexpr int LDS_BYTES = 147456, LDS_MISC = LDS_BYTES - 256;

__device__ __forceinline__ unsigned f2bf(float f) { unsigned u = __builtin_bit_cast(unsigned, f); return (u + 0x7fffu + ((u >> 16) & 1u)) >> 16; }
#ifdef CPU_EMU
__device__ __forceinline__ unsigned pk2(float lo, float hi) { return f2bf(lo) | (f2bf(hi) << 16); }
#else
typedef __bf16 bf16x2_hw __attribute__((ext_vector_type(2)));
__device__ __forceinline__ unsigned pk2(float lo, float hi) { const f32x2 v = {lo, hi}; return __builtin_bit_cast(unsigned, __builtin_convertvector(v, bf16x2_hw)); }
#endif
#ifndef CPU_EMU
__device__ __forceinline__ unsigned f2bf_hw(float f) { return pk2(f, 0.f) & 0xffffu; }
template <int CTRL> __device__ __forceinline__ float dpp_mov(float v) { return __builtin_bit_cast(float, __builtin_amdgcn_update_dpp(0, __builtin_bit_cast(int, v), CTRL, 0xf, 0xf, true)); }
__device__ __forceinline__ float sum8(float v) { v += dpp_mov<0xB1>(v); v += dpp_mov<0x4E>(v); v += dpp_mov<0x141>(v); return v; }
#else
__device__ __forceinline__ unsigned f2bf_hw(float f) { return f2bf(f); }
__device__ __forceinline__ float sum8(float v) { v += __shfl_xor(v, 1); v += __shfl_xor(v, 2); v += __shfl_xor(v, 4); return v; }
#endif
__device__ __forceinline__ float bf2f(unsigned h) { return __builtin_bit_cast(float, (h & 0xffffu) << 16); }
__device__ __forceinline__ float bflo(unsigned w) { return __builtin_bit_cast(float, w << 16); }
__device__ __forceinline__ float bfhi(unsigned w) { return __builtin_bit_cast(float, w & 0xffff0000u); }
__device__ __forceinline__ float wave_sum(float v) {
#pragma unroll
    for (int o = 1; o < 64; o <<= 1) v += __shfl_xor(v, o);
    return v;
}
__device__ __forceinline__ float sigmoidf_(float x) { return 1.f / (1.f + __expf(-x)); }
__device__ __forceinline__ float siluf_(float x) { return x / (1.f + __expf(-x)); }
__device__ __forceinline__ float softplusf_(float x) { return x > 20.f ? x : log1pf(__expf(x)); }

#ifdef CPU_EMU
#define NOINLINE
__device__ __forceinline__ unsigned char* lds_ptr() { return (unsigned char*)emu::W->lds; }
#else
#define NOINLINE __forceinline__
__device__ __forceinline__ unsigned char* lds_ptr() { extern __shared__ __attribute__((aligned(16))) unsigned char lds_dyn[]; return lds_dyn; }
#endif
#ifdef CPU_EMU
#define OPAQUE_V(x)
#define OPAQUE_S(x)
#else
#define OPAQUE_V(x) asm volatile("" : "+v"(x))
#define OPAQUE_S(x) asm volatile("" : "+s"(x))
#endif
struct Args { const float* in[N_IN]; float* out; unsigned char* ws; int ph_lo, ph_hi, dup, pad; };
namespace pg8 {
constexpr int BM = 256, BK = 64, HALF = 128, HTB = HALF * BK * 2, STAGE_BYTES = 8 * HTB, NXCD = 8, WGM = 8;
__host__ __device__ __forceinline__ int lds_byte(int r, int c) { const int st = (r >> 4) * 2 + (c >> 5), rr = r & 15, cc = c & 31, ob = rr * 64 + cc * 2; return st * 1024 + (ob ^ (((ob >> 9) & 1) << 5)); }
__host__ __device__ __forceinline__ void stage_rc(int b, int& R, int& C) { const int st = b / 1024, sb = b % 1024, swz = sb ^ (((sb >> 9) & 1) << 5); R = (st >> 1) * 16 + swz / 64; C = (st & 1) * 32 + (swz % 64) / 2; }
__host__ __device__ __forceinline__ int perm32(int rho) { const int n = rho >> 4, i = rho & 15; return 8 * (i >> 2) + 4 * n + (i & 3); }
struct Unit { int pm, pn; };
struct Gemm { const bf16_t* A; const bf16_t* Bt; int M, N, K; };
struct StaticOrder {
    int nM, nN, nwg, G, c;
    __host__ __device__ void init(int M, int N, int G_, int c_) { nM = M / BM; nN = N / BM; nwg = nM * nN; G = G_; c = c_; }
    __host__ __device__ bool next(int i, Unit& u) const {
        const long L = (long)i * G + c; if (L >= nwg) return false;
        int wgid = (int)L; { const int q = nwg / NXCD, r = nwg % NXCD, xcd = wgid % NXCD, off = wgid / NXCD; wgid = (xcd < r ? xcd * (q + 1) : r * (q + 1) + (xcd - r) * q) + off; }
        const int nig = WGM * nN, gid = wgid / nig, fm = gid * WGM, gsz = (nM - fm) < WGM ? (nM - fm) : WGM;
        u.pm = fm + ((wgid % nig) % gsz); u.pn = (wgid % nig) / gsz; return true;
    }
};
template <int ACT  > struct EpiBf16 {
    static constexpr bool AFTER_DRAIN = false;
    bf16_t* O; int ldc; const float* ssq; const float* rstd_lds;
    __device__ __forceinline__ void operator()(const f32x4 (&acc)[2][2][4][2], const Unit& u, int ui, int wr, int wc, int fr, int fq) const {
        const int row0 = u.pm * BM + wr * 64 + fr, col0 = u.pn * BM + wc * 32 + 8 * fq;
#pragma unroll
        for (int ai = 0; ai < 2; ++ai)
#pragma unroll
            for (int m = 0; m < 4; ++m) { const int row = row0 + ai * HALF + m * 16; bf16_t* rowp = O + (size_t)row * ldc + col0; const float rs = ssq ? rstd_lds[ui * 256 + (row - u.pm * BM)] : 1.f;
#pragma unroll
                for (int bj = 0; bj < 2; ++bj) { f32x4 v0 = acc[ai][bj][m][0] * rs, v1 = acc[ai][bj][m][1] * rs;
                    if (ACT == 1) {
#pragma unroll
                        for (int e = 0; e < 4; ++e) { float a = v0[e] > 0.f ? v0[e] : 0.f, b = v1[e] > 0.f ? v1[e] : 0.f; v0[e] = a * a; v1[e] = b * b; } }
                    u32x4 w; w.x = pk2(v0[0], v0[1]); w.y = pk2(v0[2], v0[3]); w.z = pk2(v1[0], v1[1]); w.w = pk2(v1[2], v1[3]);
                    *(u32x4*)(rowp + bj * HALF) = w; }
            }
    }
};
struct EpiResid {
    static constexpr bool AFTER_DRAIN = false;
    float* X; int ldc; bf16_t* XB; float* ssq;
    __device__ __forceinline__ void operator()(const f32x4 (&acc)[2][2][4][2], const Unit& u, int ui, int wr, int wc, int fr, int fq) const {
        const int row0 = u.pm * BM + wr * 64 + fr, col0 = u.pn * BM + wc * 32 + 8 * fq;
#pragma unroll
        for (int ai = 0; ai < 2; ++ai) { f32x4 xo[4][2][2];
#pragma unroll
            for (int m = 0; m < 4; ++m)
#pragma unroll
                for (int bj = 0; bj < 2; ++bj) { const f32x4* p = (const f32x4*)(X + (size_t)(row0 + ai * HALF + m * 16) * ldc + col0 + bj * HALF); xo[m][bj][0] = p[0]; xo[m][bj][1] = p[1]; }
#ifndef CPU_EMU
            asm volatile("" ::: "memory");
#endif
#pragma unroll
            for (int m = 0; m < 4; ++m) { const int row = row0 + ai * HALF + m * 16; float ss = 0.f;
#pragma unroll
                for (int bj = 0; bj < 2; ++bj) { f32x4* p = (f32x4*)(X + (size_t)row * ldc + col0 + bj * HALF); const f32x4 a = xo[m][bj][0] + acc[ai][bj][m][0], b = xo[m][bj][1] + acc[ai][bj][m][1]; p[0] = a; p[1] = b;
                    ss += (a.x * a.x + a.y * a.y) + (a.z * a.z + a.w * a.w) + (b.x * b.x + b.y * b.y) + (b.z * b.z + b.w * b.w);
                    if (XB) { u32x4 w; w.x = pk2(a.x, a.y); w.y = pk2(a.z, a.w); w.z = pk2(b.x, b.y); w.w = pk2(b.z, b.w); *(u32x4*)(XB + (size_t)row * ldc + col0 + bj * HALF) = w; } }
                ss += __shfl_xor(ss, 16); ss += __shfl_xor(ss, 32);
                if (ssq && fq == 0) ssq[(size_t)row * 32 + 4 * u.pn + wc] = ss; }
#ifndef CPU_EMU
            asm volatile("" ::: "memory");
#endif
        }
    }
};
constexpr f32x16 Z16c = {0.f, 0.f, 0.f, 0.f, 0.f, 0.f, 0.f, 0.f, 0.f, 0.f, 0.f, 0.f, 0.f, 0.f, 0.f, 0.f};
struct EpiCmp {
    static constexpr bool AFTER_DRAIN = true; static constexpr int TP = 264, RPS = 2 * NCHK_P;
    bf16_t* KC; const bf16_t* W2T; const float* cbp; int kv;
    __device__ __forceinline__ void fused(const f32x4 (&acc)[2][2][4][2], const Unit& u, unsigned char* ldsb, int wid, int lane, int wr, int wc, int fr, int fq) const {
        static_assert(NCHK_P == NCHK_S && 256 % RPS == 0, "compression tile = whole sequences");
        bf16_t* T = (bf16_t*)ldsb; float* CB = (float*)(ldsb + 256 * TP * 2); const int tid = wid * 64 + lane;
#pragma unroll
        for (int ai = 0; ai < 2; ++ai)
#pragma unroll
            for (int m = 0; m < 4; ++m) { const int row = ai * HALF + wr * 64 + m * 16 + fr;
#pragma unroll
                for (int bj = 0; bj < 2; ++bj)
#pragma unroll
                    for (int n = 0; n < 2; ++n) { const f32x4 v = acc[ai][bj][m][n]; u32x2 w; w.x = pk2(v.x, v.y); w.y = pk2(v.z, v.w); *(u32x2*)(T + row * TP + bj * HALF + wc * 32 + 8 * fq + 4 * n) = w; } }
        if (tid < 128) { float sb = 0.f; for (int q = 0; q < 32; ++q) sb += cbp[q * 128 + tid]; CB[tid] = sb; }
        LDS_BARRIER();
        for (int it = tid; it < 256 * 16; it += NT) { const int R = it >> 4, c8 = it & 15, i = (R % RPS) >> 1;
            if (i < NCHK_P - 1) { const u32x4 a = *(const u32x4*)(T + R * TP + 8 * c8), bb = *(const u32x4*)(T + (R + 2) * TP + 128 + 8 * c8); const float* cb = CB + 8 * c8; u32x4 pk;
                pk.x = pk2(siluf_(bflo(a.x) + bflo(bb.x) + cb[0]), siluf_(bfhi(a.x) + bfhi(bb.x) + cb[1])); pk.y = pk2(siluf_(bflo(a.y) + bflo(bb.y) + cb[2]), siluf_(bfhi(a.y) + bfhi(bb.y) + cb[3]));
                pk.z = pk2(siluf_(bflo(a.z) + bflo(bb.z) + cb[4]), siluf_(bfhi(a.z) + bfhi(bb.z) + cb[5])); pk.w = pk2(siluf_(bflo(a.w) + bflo(bb.w) + cb[6]), siluf_(bfhi(a.w) + bfhi(bb.w) + cb[7]));
                *(u32x4*)(T + R * TP + 8 * c8) = pk; } }
        LDS_BARRIER();
        { const int r = lane & 31, hi = lane >> 5; f32x16 o0 = Z16c, o1 = Z16c; const bf16_t* ap = T + (32 * wid + r) * TP + 8 * hi; const bf16_t* b0 = W2T + (size_t)r * 128 + 8 * hi; const bf16_t* b1 = b0 + 32 * 128;
#pragma unroll
            for (int k = 0; k < 128; k += 16) { const bf16x8 a = *(const bf16x8*)(ap + k); o0 = MFMA32(a, *(const bf16x8*)(b0 + k), o0); o1 = MFMA32(a, *(const bf16x8*)(b1 + k), o1); }
#pragma unroll
            for (int q = 0; q < 16; ++q) { const int R = 32 * wid + (q & 3) + 8 * (q >> 2) + 4 * hi, i = (R % RPS) >> 1, g = R & 1, seqa = u.pm * (256 / RPS) + R / RPS;
                if (i < NCHK_P - 1 && seqa < BATCH + DEC_BATCH) { bf16_t* dst = KC + (((size_t)kv * (BATCH + DEC_BATCH) + seqa) * 128 + i) * 128 + g * 64 + r; dst[0] = (bf16_t)f2bf(o0[q]); dst[32] = (bf16_t)f2bf(o1[q]); } } }
        LDS_BARRIER();
    }
};
__device__ __forceinline__ void epi_prepass(EpiCmp&, const StaticOrder&) {}
template <class Epi, bool ALIGN_EPI>
__device__ __forceinline__ void gemm_phase(LAS unsigned char* lds, const Gemm g, const StaticOrder& S, const Epi& E) {
    int tid_ = threadIdx.x;
#ifndef CPU_EMU
    asm volatile("" : "+v"(tid_));
#endif
    const int tid = tid_, wid = RFL(tid >> 6), lane = tid & 63, wr = wid >> 2, wc = wid & 3, fr = lane & 15, fq = lane >> 4;
    const int K = g.K, nt = K / BK;
    unsigned voffA[2], voffB[2];
#pragma unroll
    for (int i = 0; i < 2; ++i) { int R, C; stage_rc(tid * 16 + i * 8192, R, C); const int Rb = (R & ~31) + perm32(R & 31);
        voffA[i] = (unsigned)(R * K + C) * 2u; voffB[i] = (unsigned)(Rb * K + C) * 2u; }
    const size_t kstep = (size_t)(BK * 2), hstep = (size_t)HALF * K * 2, tstep = 2 * hstep;
    const unsigned ldsw = (unsigned)wid * 1024u;
    const int aoff = lds_byte(wr * 64 + fr, fq * 8), boff = lds_byte(wc * 32 + fr, fq * 8);
#define PG8_SA(b, h) (((b) * 2 + (h)) * HTB)
#define PG8_SB(b, h) ((4 + (b) * 2 + (h)) * HTB)
#define PG8_STAGE(bufoff, gbase, voff) do { _Pragma("unroll") for (int _i = 0; _i < 2; ++_i) GLDS16((const char*)(gbase) + (voff)[_i], lds + (bufoff) + ldsw + _i * 8192); } while (0)
#define PG8_LDA(dst, b, h) do { _Pragma("unroll") for (int m = 0; m < 4; ++m) _Pragma("unroll") for (int k = 0; k < 2; ++k) dst[m][k] = *(const LAS bf16x8*)(lds + PG8_SA(b, h) + aoff + m * 2048 + k * 1024); } while (0)
#define PG8_LDB(dst, b, h) do { _Pragma("unroll") for (int n = 0; n < 2; ++n) _Pragma("unroll") for (int k = 0; k < 2; ++k) dst[n][k] = *(const LAS bf16x8*)(lds + PG8_SB(b, h) + boff + n * 2048 + k * 1024); } while (0)
#define PG8_MMA(ai, bj, At, Bt) do { SETPRIO(1); _Pragma("unroll") for (int m = 0; m < 4; ++m) _Pragma("unroll") for (int n = 0; n < 2; ++n) _Pragma("unroll") for (int k = 0; k < 2; ++k) \
        acc[ai][bj][m][n] = MFMA16(Bt[n][k], At[m][k], acc[ai][bj][m][n]); SETPRIO(0); } while (0)
    Unit cur, nxt; int ui = 0;
    if (!S.next(0, cur)) return;
    f32x4 acc[2][2][4][2];
#pragma unroll
    for (int a = 0; a < 2; ++a)
#pragma unroll
        for (int b = 0; b < 2; ++b)
#pragma unroll
            for (int m = 0; m < 4; ++m)
#pragma unroll
                for (int n = 0; n < 2; ++n) acc[a][b][m][n] = (f32x4){0.f, 0.f, 0.f, 0.f};
    bf16x8 At[4][2], B0[2][2], B1[2][2];
    const char* cA = (const char*)g.A + (size_t)cur.pm * tstep; const char* cB = (const char*)g.Bt + (size_t)cur.pn * tstep;
    PG8_STAGE(PG8_SB(0, 0), cB, voffB); PG8_STAGE(PG8_SB(0, 1), cB + hstep, voffB); PG8_STAGE(PG8_SA(0, 0), cA, voffA); PG8_STAGE(PG8_SA(0, 1), cA + hstep, voffA);
    if (wr == 1) S_BARRIER();
    WAIT_VM(2); S_BARRIER();
    PG8_STAGE(PG8_SB(1, 0), cB + kstep, voffB); PG8_STAGE(PG8_SA(1, 0), cA + kstep, voffA); PG8_STAGE(PG8_SB(1, 1), cB + hstep + kstep, voffB);
    WAIT_VM(6); S_BARRIER();
    for (;;) {
        const bool has_next = S.next(ui + 1, nxt);
        const char* nA = has_next ? (const char*)g.A + (size_t)nxt.pm * tstep : cA; const char* nB = has_next ? (const char*)g.Bt + (size_t)nxt.pn * tstep : cB;
        for (int t = 0; t < nt; t += 2) {
            const bool last = (t == nt - 2);
            const char* a1 = cA + (size_t)(t + 1) * kstep;
            const char* a2 = last ? nA : cA + (size_t)(t + 2) * kstep; const char* b2 = last ? nB : cB + (size_t)(t + 2) * kstep;
            const char* a3 = a2 + kstep; const char* b3 = b2 + kstep;
            PG8_LDB(B0, 0, 0); PG8_LDB(B1, 0, 1); SCHED_BARRIER(); PG8_LDA(At, 0, 0); PG8_STAGE(PG8_SA(1, 1), a1 + hstep, voffA);
            WAIT_VM(8); WAIT_LGKM(0); S_BARRIER(); PG8_MMA(0, 0, At, B0); PG8_MMA(0, 1, At, B1); S_BARRIER(); SCHED_BARRIER();
            PG8_LDA(At, 0, 1); PG8_STAGE(PG8_SB(0, 0), b2, voffB); PG8_STAGE(PG8_SB(0, 1), b2 + hstep, voffB); PG8_STAGE(PG8_SA(0, 0), a2, voffA);
            WAIT_VM(8); WAIT_LGKM(0); S_BARRIER(); PG8_MMA(1, 0, At, B0); PG8_MMA(1, 1, At, B1); S_BARRIER(); SCHED_BARRIER();
            PG8_LDB(B0, 1, 0); PG8_LDB(B1, 1, 1); SCHED_BARRIER(); PG8_LDA(At, 1, 0); PG8_STAGE(PG8_SA(0, 1), a2 + hstep, voffA);
            WAIT_VM(8); WAIT_LGKM(0); S_BARRIER(); PG8_MMA(0, 0, At, B0); PG8_MMA(0, 1, At, B1); S_BARRIER(); SCHED_BARRIER();
            PG8_LDA(At, 1, 1); PG8_STAGE(PG8_SB(1, 0), b3, voffB); PG8_STAGE(PG8_SB(1, 1), b3 + hstep, voffB); PG8_STAGE(PG8_SA(1, 0), a3, voffA);
            WAIT_VM(8); WAIT_LGKM(0); S_BARRIER(); PG8_MMA(1, 0, At, B0); PG8_MMA(1, 1, At, B1); S_BARRIER(); SCHED_BARRIER();
        }
        if (ALIGN_EPI) { if (wr == 0) S_BARRIER(); }
        if constexpr (!Epi::AFTER_DRAIN) E(acc, cur, ui, wr, wc, fr, fq);
        if (!has_next) break;
#pragma unroll
        for (int a = 0; a < 2; ++a)
#pragma unroll
            for (int b = 0; b < 2; ++b)
#pragma unroll
                for (int m = 0; m < 4; ++m)
#pragma unroll
                    for (int n = 0; n < 2; ++n) acc[a][b][m][n] = (f32x4){0.f, 0.f, 0.f, 0.f};
        cur = nxt; cA = nA; cB = nB; ++ui;
        if (ALIGN_EPI) { if (wr == 1) S_BARRIER(); }
    }
    WAIT_VM(0);
    if (!ALIGN_EPI) { if (wr == 0) S_BARRIER(); }
    S_BARRIER();
    if constexpr (Epi::AFTER_DRAIN) E.fused(acc, cur, (unsigned char*)lds, wid, lane, wr, wc, fr, fq);
#undef PG8_SA
#undef PG8_SB
#undef PG8_STAGE
#undef PG8_LDA
#undef PG8_LDB
#undef PG8_MMA
}
template <int ACT> __device__ __forceinline__ void epi_prepass(EpiBf16<ACT>& E, const StaticOrder& S) {
    float* tab = (float*)(lds_ptr() + STAGE_BYTES); E.rstd_lds = tab;
    if (E.ssq) { Unit u; const int t = threadIdx.x;
        for (int i = 0; i < 15 && S.next(i, u); ++i) if (t < 256) { const f32x4* q = (const f32x4*)(E.ssq + (size_t)(u.pm * BM + t) * 32); float tt = 0.f;
#pragma unroll
            for (int j = 0; j < 8; ++j) { const f32x4 a = q[j]; tt += (a.x + a.y) + (a.z + a.w); }
            tab[i * 256 + t] = 1.f / sqrtf(tt * (1.f / 1024.f) + 1e-5f); }
        __syncthreads(); }
}
__device__ __forceinline__ void epi_prepass(EpiResid&, const StaticOrder&) {}
template <class Epi> __device__ NOINLINE void gemm_call(const bf16_t* A, const bf16_t* Bt, int M, int N, int K, Epi E, int G, int bid) {
    OPAQUE_S(G); OPAQUE_S(bid);
    Gemm g{A, Bt, M, N, K}; StaticOrder S; S.init(M, N, G, bid);
    epi_prepass(E, S);
    gemm_phase<Epi, true>((LAS unsigned char*)lds_ptr(), g, S, E);
}
}
struct Frame {
    unsigned char* lds; int tid, lane, wave, G, bid, gw, NGW;
    const float* const* in; float* out; unsigned char* ws;
};
#define WSP(T, off) ((T*)(F.ws + (off)))
#ifdef CPU_EMU
#define UNIT_BEGIN(F)
#else
#define UNIT_BEGIN(F) do { int z_ = 0; asm volatile("s_mov_b32 %0, 0" : "=s"(z_)); F.ws += z_; F.out += z_; F.lds += z_; int t_ = F.tid; OPAQUE_V(t_); F.tid = t_; F.lane = t_ & 63; F.wave = RFL(t_ >> 6); } while (0)
#endif
__device__ __forceinline__ void frame_refresh(Frame& F) {
    int t = threadIdx.x; OPAQUE_V(t); F.tid = t; F.lane = t & 63; F.wave = RFL(t >> 6); { int b_ = blockIdx.x, g_ = gridDim.x; OPAQUE_S(b_); OPAQUE_S(g_); F.bid = b_; F.G = g_; } F.NGW = F.G * NWAVE; F.gw = F.bid * NWAVE + F.wave; F.lds = lds_ptr();
}
__device__ __forceinline__ void tr_job(Frame& F, int& base, const float* src, int ldsrc, int nvalid, int npad, int K, bf16_t* dst, int rowoff, const float* gk = nullptr) {
    float* scr = (float*)(F.lds + F.wave * 16640);
    const int nblk = npad / 64, nitems = (K / 64) * nblk, lane = F.lane, rr = lane >> 4, c4 = lane & 15;
    int it = base + (((F.gw - base) % F.NGW) + F.NGW) % F.NGW;
    for (; it < base + nitems; it += F.NGW) {
        const int item = it - base, kb = item / nblk, nb = item % nblk, k0 = 64 * kb, n0 = 64 * nb; const bool ok = n0 + 4 * c4 < nvalid;
        f32x4 v[16];
#pragma unroll
        for (int i = 0; i < 16; ++i) v[i] = ok ? *(const f32x4*)(src + (size_t)(k0 + 4 * i + rr) * ldsrc + n0 + 4 * c4) : (f32x4){0.f, 0.f, 0.f, 0.f};
#pragma unroll
        for (int i = 0; i < 16; ++i) { const float g = gk ? gk[k0 + 4 * i + rr] : 1.f; float* p = scr + (4 * i + rr) * 65 + 4 * c4; p[0] = v[i].x * g; p[1] = v[i].y * g; p[2] = v[i].z * g; p[3] = v[i].w * g; }
        WAVE_SYNC();
        const int c = lane & 7;
#pragma unroll
        for (int j = 0; j < 8; ++j) { const int n = (lane >> 3) + 8 * j; const float* q = scr + (8 * c) * 65 + n;
            u32x4 o; o.x = pk2(q[0 * 65], q[1 * 65]); o.y = pk2(q[2 * 65], q[3 * 65]); o.z = pk2(q[4 * 65], q[5 * 65]); o.w = pk2(q[6 * 65], q[7 * 65]);
            *(u32x4*)(dst + (size_t)(rowoff + n0 + n) * K + k0 + 8 * c) = o; }
        WAVE_SYNC();
    }
    base += nitems;
}
__device__ __forceinline__ void norm_row(Frame& F, const float* xrow, const float* g, bf16_t* obf, float* of32, float* xcopy) {
    const f32x4* xr = (const f32x4*)xrow + F.lane; f32x4 v[4]; float s = 0.f;
#pragma unroll
    for (int j = 0; j < 4; ++j) { v[j] = xr[64 * j]; s += (v[j].x * v[j].x + v[j].y * v[j].y) + (v[j].z * v[j].z + v[j].w * v[j].w); }
    const float r = 1.f / sqrtf(wave_sum(s) * (1.f / DM) + EPS);
#pragma unroll
    for (int j = 0; j < 4; ++j) { const f32x4 gg = ((const f32x4*)g)[F.lane + 64 * j]; f32x4 y = v[j] * r * gg;
        if (xcopy) ((f32x4*)xcopy)[F.lane + 64 * j] = v[j];
        if (of32) ((f32x4*)of32)[F.lane + 64 * j] = y;
        if (obf) { u32x2 w; w.x = pk2(y.x, y.y); w.y = pk2(y.z, y.w); ((u32x2*)obf)[F.lane + 64 * j] = w; } }
}
__device__ NOINLINE void ph_norm(Frame F, const float* g, bool final_out) { frame_refresh(F);
    float* X = WSP(float, WS_X); bf16_t* XN = WSP(bf16_t, WS_XN);
    for (int m = F.gw; m < MT; m += F.NGW) norm_row(F, X + (size_t)m * DM, g, final_out ? nullptr : XN + (size_t)m * DM, final_out ? F.out + O_YP + (size_t)m * DM : nullptr, nullptr);
}
__device__ NOINLINE void ph_prologue(Frame F, int only) { frame_refresh(F);
    int base = 0;
    if (only == 0 || only == 1) {
    for (int i = 0; i < N_SSM; ++i) {
        tr_job(F, base, F.in[I_WINE] + (size_t)i * DM * IN_EVEN, IN_EVEN, IN_EVEN, IN_EVEN_PAD, DM, WSP(bf16_t, WS_WINE) + (size_t)i * IN_EVEN_PAD * DM, 0, F.in[I_NME] + (size_t)i * DM);
        tr_job(F, base, F.in[I_WOUTE] + (size_t)i * MIXE * DM, DM, DM, DM, MIXE, WSP(bf16_t, WS_WOUTE) + (size_t)i * DM * MIXE, 0);
    }
    for (int i = 0; i < N_ATT; ++i) {
        tr_job(F, base, F.in[I_WINO] + (size_t)i * DM * IN_ODD, IN_ODD, IN_ODD, IN_ODD_PAD, DM, WSP(bf16_t, WS_WINO) + (size_t)i * IN_ODD_PAD * DM, 0, F.in[I_NMO] + (size_t)i * DM);
        tr_job(F, base, F.in[I_WOUTO] + (size_t)i * DM * DM, DM, DM, DM, DM, WSP(bf16_t, WS_WOUTO) + (size_t)i * DM * DM, 0);
        for (int kv = 0; kv < 2; ++kv) for (int h = 0; h < 2; ++h)
            tr_job(F, base, F.in[I_CW1] + ((size_t)(i * 2 + kv) * 2048 + h * 1024) * 128, 128, 128, 128, 1024, WSP(bf16_t, WS_CW1) + (size_t)(i * 2 + kv) * 256 * 1024, h * 128);
    }
    for (int l = 0; l < DEPTH; ++l) {
        tr_job(F, base, F.in[I_WUP] + (size_t)l * DM * DFF, DFF, DFF, DFF, DM, WSP(bf16_t, WS_WUP) + (size_t)l * DFF * DM, 0, F.in[I_NMLP] + (size_t)l * DM);
        tr_job(F, base, F.in[I_WDN] + (size_t)l * DFF * DM, DM, DM, DM, DFF, WSP(bf16_t, WS_WDN) + (size_t)l * DM * DFF, 0);
    }
    }
    if (only == 0 || only == 2) for (int m = F.gw; m < MT; m += F.NGW) { const float* src = m < MP ? F.in[I_XP] + (size_t)m * DM : F.in[I_XS] + (size_t)(m - MP) * DM; float ss = 0.f;
#pragma unroll
        for (int j = 0; j < 4; ++j) { const f32x4 v = ((const f32x4*)src)[F.lane + 64 * j]; ss += (v.x * v.x + v.y * v.y) + (v.z * v.z + v.w * v.w); ((f32x4*)(WSP(float, WS_X) + (size_t)m * DM))[F.lane + 64 * j] = v;
            u32x2 w; w.x = pk2(v.x, v.y); w.y = pk2(v.z, v.w); ((u32x2*)(WSP(bf16_t, WS_XN) + (size_t)m * DM))[F.lane + 64 * j] = w; }
        ss = wave_sum(ss); if (F.lane < 32) WSP(float, WS_SSQ)[(size_t)m * 32 + F.lane] = F.lane == 0 ? ss : 0.f; }
    if (only != 0 && only != 3) return;
    const int gt = F.bid * NT + F.tid, GT = F.G * NT;
    for (int e = gt; e < N_SSM * S5G * S5P; e += GT) { const int i = e / (S5G * S5P), g = (e / S5P) % S5G, p = e % S5P;
        const float are = F.in[I_S5ARE][e], aim = F.in[I_S5AIM][e], dt = __expf(F.in[I_S5LDT][i * S5G + g]);
        const double rev = (double)aim * (double)dt * 0.15915494309189535, frv = rev - floor(rev); const float th = (float)(frv * 6.283185307179586);
        const float cth = cosf(th), sth = sinf(th), sh = sinf(0.5f * th), cm1 = -2.f * sh * sh, em1 = expm1f(are * dt), mag = em1 + 1.f;
        const float abr = mag * cth, abi = mag * sth, abm1 = em1 * cth + cm1, den = are * are + aim * aim;
        const float fre = (abm1 * are + abi * aim) / den, fim = (abi * are - abm1 * aim) / den;
        WSP(float, WS_S5A)[e * 2] = (float)abr; WSP(float, WS_S5A)[e * 2 + 1] = (float)abi;
        bf16_t* Bt = WSP(bf16_t, WS_S5B) + (size_t)(i * S5G + g) * 128 * 16;
        for (int c = 0; c < 16; ++c) { const float br = F.in[I_S5BRE][(size_t)e * 16 + c], bi = F.in[I_S5BIM][(size_t)e * 16 + c];
            Bt[(2 * p) * 16 + c] = (bf16_t)f2bf((float)(fre * br - fim * bi)); Bt[(2 * p + 1) * 16 + c] = (bf16_t)f2bf((float)(fre * bi + fim * br)); } }
    for (int e = gt; e < N_SSM * S5G * 16 * 128; e += GT) { const int k = e % 128, c = (e / 128) % 16, ig = e / 2048;
        const float v = (k & 1) == 0 ? F.in[I_S5CRE][((size_t)ig * 16 + c) * 64 + (k >> 1)] : -F.in[I_S5CIM][((size_t)ig * 16 + c) * 64 + (k >> 1)];
        WSP(bf16_t, WS_S5C)[e] = (bf16_t)f2bf(v); }
    for (int e = gt; e < NROPE * 8; e += GT) { const int pos = e >> 3, i = e & 7; double inv = 1.0; for (int q = 0; q < i; ++q) inv *= 0.1939227447486858;
        const double ang = (double)pos * inv, rev = ang * 0.15915494309189535, fr = rev - (double)(long long)rev; const float rf = (float)(fr * 6.283185307179586);
        WSP(float, WS_ROPE)[pos * 16 + i] = cosf(rf); WSP(float, WS_ROPE)[pos * 16 + 8 + i] = sinf(rf); }
    for (int e = gt; e < N_ATT * 2 * 64 * 128; e += GT) { const int n = e & 127, d = (e >> 7) & 63, ik = e >> 13; WSP(bf16_t, WS_CW2T)[e] = (bf16_t)f2bf(F.in[I_CW2][((size_t)ik * 128 + n) * 64 + d]); }
    for (int e = gt; e < N_ATT * 2 * 32 * 128; e += GT) { const int n = e % 128, q = (e / 128) % 32, ik = e / 4096; const float* pe = F.in[I_CPOS] + (size_t)ik * 2048 + 64 * q; const float* w = F.in[I_CW1] + ((size_t)ik * 2048 + 64 * q) * 128 + n;
        float s = 0.f;
#pragma unroll 8
        for (int k = 0; k < 64; ++k) s += pe[k] * w[(size_t)k * 128];
        WSP(float, WS_CBIAS)[e] = s; }
}
template <bool SWA = false, bool SWB = false>
__device__ __forceinline__ void mma32_lds(f32x16& acc, const bf16_t* A, int pa, const bf16_t* Bn, int pb, int K, int lane, int arow0 = 0, int brow0 = 0) {
    const int r = lane & 31, h = lane >> 5; const int ar = arow0 + r, br = brow0 + r; const bf16_t* ap = A + (SWA ? ar * pa : r * pa + 8 * h); const bf16_t* bp = Bn + (SWB ? br * pb : r * pb + 8 * h);
    const int fa = (ar >> 3) & 15, fb = (br >> 3) & 15;
    for (int k = 0; k < K; k += 16) { const bf16x8 a = *(const bf16x8*)(SWA ? ap + ((((k >> 3) + h) ^ fa) << 3) : ap + k), b = *(const bf16x8*)(SWB ? bp + ((((k >> 3) + h) ^ fb) << 3) : bp + k); acc = MFMA32(a, b, acc); }
}
__device__ __forceinline__ int swz(int row, int k, int P) { return row * P + ((((k >> 3) ^ ((row >> 3) & 15)) << 3) | (k & 7)); }
__device__ __forceinline__ int crow(int reg, int hi) { return (reg & 3) + 8 * (reg >> 2) + 4 * hi; }
constexpr f32x16 Z16 = {0.f, 0.f, 0.f, 0.f, 0.f, 0.f, 0.f, 0.f, 0.f, 0.f, 0.f, 0.f, 0.f, 0.f, 0.f, 0.f};

template <int ACT  >
__device__ __forceinline__ void gemm_small(Frame& F, const bf16_t* A, const bf16_t* Bt, int N, int K, void* Ov, int ldc, bf16_t* XB, float* ssq) {
    constexpr int SP = 136, SBUF = 96 * SP * 2;
    float* RED = (float*)(F.lds + 2 * SBUF);
    const int lane = F.lane, w = F.wave, r = lane & 31, hi = lane >> 5, nch = K >> 7; constexpr int NPM = MS / 64;
    for (int u = F.bid; u < NPM * (N / 32); u += F.G) { const int pm = u % NPM, pn = u / NPM, row0 = 64 * pm, col0 = 32 * pn;
        const bf16_t* src[3]; int dsto[3];
#pragma unroll
        for (int q = 0; q < 3; ++q) { const int p = F.tid + NT * q, row = p >> 4, c = p & 15; src[q] = (row < 64 ? A + (size_t)(row0 + row) * K : Bt + (size_t)(col0 + row - 64) * K) + 8 * c; dsto[q] = row * SP + 8 * c; }
        constexpr int D = 4;
        u32x4 rg[D][3];
#pragma unroll
        for (int j = 0; j < D; ++j)
#pragma unroll
            for (int q = 0; q < 3; ++q) rg[j][q] = *(const u32x4*)(src[q] + (size_t)j * 128);
        LDS_BARRIER();
#pragma unroll
        for (int q = 0; q < 3; ++q) *(u32x4*)((bf16_t*)F.lds + dsto[q]) = rg[0][q];
        if (D < nch) {
#pragma unroll
            for (int q = 0; q < 3; ++q) rg[0][q] = *(const u32x4*)(src[q] + (size_t)D * 128); }
        LDS_BARRIER();
        f32x16 acc0 = Z16, acc1 = Z16;
        for (int c0 = 0; c0 < nch; c0 += D) {
#pragma unroll
            for (int j = 0; j < D; ++j) { const int c = c0 + j; const bf16_t* sb = (const bf16_t*)(F.lds + (j & 1) * SBUF);
                const bf16x8 bb = *(const bf16x8*)(sb + (64 + r) * SP + 16 * w + 8 * hi), x0 = *(const bf16x8*)(sb + r * SP + 16 * w + 8 * hi), x1 = *(const bf16x8*)(sb + (32 + r) * SP + 16 * w + 8 * hi);
                acc0 = MFMA32(x0, bb, acc0); acc1 = MFMA32(x1, bb, acc1);
                if (c + 1 < nch) { bf16_t* db = (bf16_t*)(F.lds + ((j + 1) & 1) * SBUF); constexpr int DD = D; const int jn = (j + 1) % DD;
#pragma unroll
                    for (int q = 0; q < 3; ++q) *(u32x4*)(db + dsto[q]) = rg[jn][q];
                    if (c + 1 + D < nch) {
#pragma unroll
                        for (int q = 0; q < 3; ++q) rg[jn][q] = *(const u32x4*)(src[q] + (size_t)(c + 1 + D) * 128); }
                    LDS_BARRIER(); } } }
#pragma unroll
        for (int i = 0; i < 16; ++i) { RED[(w * 64 + crow(i, hi)) * 33 + r] = acc0[i]; RED[(w * 64 + 32 + crow(i, hi)) * 33 + r] = acc1[i]; }
        LDS_BARRIER();
        { const int row = F.tid >> 3, c4 = (F.tid & 7) * 4; float v[4];
#pragma unroll
            for (int e = 0; e < 4; ++e) { float s = 0.f;
#pragma unroll
                for (int ww = 0; ww < 8; ++ww) s += RED[(ww * 64 + row) * 33 + c4 + e];
                v[e] = s; }
            const size_t o = (size_t)(row0 + row) * ldc + col0 + c4;
            if (ACT == 2) { f32x4* p = (f32x4*)((float*)Ov + o); f32x4 x = *p; x.x += v[0]; x.y += v[1]; x.z += v[2]; x.w += v[3]; *p = x;
                float ss = (x.x * x.x + x.y * x.y) + (x.z * x.z + x.w * x.w); ss += __shfl_xor(ss, 1); ss += __shfl_xor(ss, 2); ss += __shfl_xor(ss, 4);
                if (XB) { u32x2 pk; pk.x = pk2(x.x, x.y); pk.y = pk2(x.z, x.w); *(u32x2*)(XB + o) = pk; }
                if (ssq && (F.tid & 7) == 0) ssq[(size_t)(row0 + row) * 32 + pn] = ss; }
            else { float rs = 1.f;
                if (ssq) { const f32x4* q = (const f32x4*)(ssq + (size_t)(row0 + row) * 32); float t = 0.f;
#pragma unroll
                    for (int j = 0; j < 8; ++j) { const f32x4 a = q[j]; t += (a.x + a.y) + (a.z + a.w); }
                    rs = 1.f / sqrtf(t * (1.f / 1024.f) + EPS); }
#pragma unroll
                for (int e = 0; e < 4; ++e) { float t = v[e] * rs; if (ACT == 1) { t = t > 0.f ? t : 0.f; t = t * t; } v[e] = t; }
                u32x2 pk; pk.x = pk2(v[0], v[1]); pk.y = pk2(v[2], v[3]); *(u32x2*)((bf16_t*)Ov + o) = pk; } }
    }
}
__device__ NOINLINE void ph_gemm_small(Frame F, int act, const bf16_t* A, const bf16_t* Bt, int N, int K, void* O, int ldc, bf16_t* XB, float* ssq) { frame_refresh(F);
    if (act == 0) gemm_small<0>(F, A, Bt, N, K, O, ldc, XB, ssq); else if (act == 1) gemm_small<1>(F, A, Bt, N, K, O, ldc, XB, ssq); else gemm_small<2>(F, A, Bt, N, K, O, ldc, XB, ssq);
}
__device__ __forceinline__ void s5_prompt_unit(Frame& F, int li, int b, int g) { UNIT_BEGIN(F);
    constexpr int BUP = 132, HBP = 136, BTP = 24, CTP = 136;
    float* BU = (float*)F.lds;
    bf16_t* HB = (bf16_t*)(F.lds + 128 * BUP * 4);
    float* Y = (float*)(F.lds + 128 * BUP * 4 + 128 * HBP * 2);
    bf16_t* BT = (bf16_t*)((unsigned char*)Y + 128 * 20 * 4);
    bf16_t* CT = BT + 128 * BTP;
    float* GW = (float*)(CT + 16 * CTP);
    float* SEG = GW + 576;
    bf16_t* UL = (bf16_t*)(SEG + 8 * 128);
    const bf16_t* PROJ = WSP(bf16_t, WS_PROJ); bf16_t* YMIX = WSP(bf16_t, WS_YMIX);
    const int tid = F.tid, lane = F.lane, w = F.wave, ig = li * S5G + g;
    LDS_BARRIER();
    for (int e = tid; e < 128 * 16; e += NT) BT[(e >> 4) * BTP + (e & 15)] = WSP(bf16_t, WS_S5B)[(size_t)ig * 2048 + e];
    for (int e = tid; e < 16 * 128; e += NT) CT[(e >> 7) * CTP + (e & 127)] = WSP(bf16_t, WS_S5C)[(size_t)ig * 2048 + e];
    for (int e = tid; e < 512; e += NT) GW[e] = F.in[I_GLUW][(size_t)ig * 512 + e];
    if (tid < 32) GW[512 + tid] = F.in[I_GLUB][ig * 32 + tid];
    if (tid < 16) GW[544 + tid] = F.in[I_S5D][li * S5W + g * 16 + tid];
    const float ar = WSP(float, WS_S5A)[(ig * S5P + lane) * 2], ai = WSP(float, WS_S5A)[(ig * S5P + lane) * 2 + 1];
    float a16r = ar, a16i = ai;
#pragma unroll
    for (int q = 0; q < 4; ++q) { const float nr = a16r * a16r - a16i * a16i, ni = 2.f * a16r * a16i; a16r = nr; a16i = ni; }
    float cr = 0.f, ci = 0.f;
    LDS_BARRIER();
    float gl[16], gg[16]; const float gl0 = GW[512 + (tid & 15)], gg0 = GW[528 + (tid & 15)];
#pragma unroll
    for (int c = 0; c < 16; ++c) { gl[c] = GW[c * 32 + (tid & 15)]; gg[c] = GW[c * 32 + 16 + (tid & 15)]; }
    bf16x8 ua[2];
#pragma unroll
    for (int q = 0; q < 2; ++q) { const int tt = (2 * w + q) >> 2; ua[q] = *(const bf16x8*)(PROJ + ((size_t)b * SEQ + 32 * tt + (lane & 31)) * IN_EVEN_PAD + g * 16 + 8 * (lane >> 5)); }
    for (int ch = 0; ch < SEQ / 128; ++ch) {
        const size_t tok0 = (size_t)b * SEQ + ch * 128;
#pragma unroll
        for (int q = 0; q < 2; ++q) { const int tile = 2 * w + q, tt = tile >> 2, st = tile & 3, r = lane & 31, h = lane >> 5;
            const bf16x8 a = ua[q];
            if (st == 0) *(bf16x8*)(UL + (32 * tt + r) * 16 + 8 * h) = a;
            const bf16x8 bb = *(const bf16x8*)(BT + (32 * st + r) * BTP + 8 * h);
            f32x16 d = MFMA32(a, bb, Z16);
#pragma unroll
            for (int i = 0; i < 16; ++i) BU[(32 * tt + crow(i, h)) * BUP + 32 * st + r] = d[i]; }
        if (ch + 1 < SEQ / 128) {
#pragma unroll
            for (int q = 0; q < 2; ++q) { const int tt = (2 * w + q) >> 2; ua[q] = *(const bf16x8*)(PROJ + (tok0 + 128 + 32 * tt + (lane & 31)) * IN_EVEN_PAD + g * 16 + 8 * (lane >> 5)); } }
        LDS_BARRIER();
        float lr[16], lq[16]; { float hr = 0.f, hi = 0.f;
#pragma unroll
            for (int q = 0; q < 16; ++q) { const float br = BU[(16 * w + q) * BUP + 2 * lane], bi = BU[(16 * w + q) * BUP + 2 * lane + 1];
                const float nr = ar * hr - ai * hi + br, ni = ar * hi + ai * hr + bi; hr = nr; hi = ni; lr[q] = hr; lq[q] = hi; }
            SEG[w * 128 + 2 * lane] = hr; SEG[w * 128 + 2 * lane + 1] = hi; }
        LDS_BARRIER();
        float mr = 0.f, mi = 0.f;
#pragma unroll
        for (int v = 0; v < 8; ++v) { if (v == w) { mr = cr; mi = ci; } const float er = SEG[v * 128 + 2 * lane], ei = SEG[v * 128 + 2 * lane + 1];
            const float nr = a16r * cr - a16i * ci + er, ni = a16r * ci + a16i * cr + ei; cr = nr; ci = ni; }
#pragma unroll
        for (int q = 0; q < 16; ++q) { const float nr = ar * mr - ai * mi, ni = ar * mi + ai * mr; mr = nr; mi = ni;
            *(unsigned*)(HB + (16 * w + q) * HBP + 2 * lane) = pk2(lr[q] + mr, lq[q] + mi); }
        LDS_BARRIER();
        { const int row = lane & 15, kq = lane >> 4; f32x4 acc = {0.f, 0.f, 0.f, 0.f};
#pragma unroll
            for (int s4 = 0; s4 < 4; ++s4) { const bf16x8 a = *(const bf16x8*)(HB + (16 * w + row) * HBP + 32 * s4 + 8 * kq), bb = *(const bf16x8*)(CT + row * CTP + 32 * s4 + 8 * kq); acc = MFMA16(a, bb, acc); }
#pragma unroll
            for (int i = 0; i < 4; ++i) { const int t = 16 * w + 4 * kq + i; const float u = bf2f(UL[t * 16 + row]); Y[t * 20 + row] = acc[i] + GW[544 + row] * u; } }
        LDS_BARRIER();
#pragma unroll
        for (int q = 0; q < 4; ++q) { const int t = (tid >> 4) + 32 * q; float lin = gl0, gt = gg0; const f32x4* yp = (const f32x4*)(Y + t * 20);
#pragma unroll
            for (int c4 = 0; c4 < 4; ++c4) { const f32x4 y = yp[c4];
                lin += y.x * gl[4 * c4] + y.y * gl[4 * c4 + 1] + y.z * gl[4 * c4 + 2] + y.w * gl[4 * c4 + 3]; gt += y.x * gg[4 * c4] + y.y * gg[4 * c4 + 1] + y.z * gg[4 * c4 + 2] + y.w * gg[4 * c4 + 3]; }
            YMIX[(tok0 + t) * MIXE + g * 16 + (tid & 15)] = (bf16_t)f2bf_hw(lin * sigmoidf_(gt)); }
    }
    if (w == 0) { float* o = F.out + O_S5P + ((size_t)(li * BATCH + b) * S5G + g) * 128 + lane * 2; o[0] = cr; o[1] = ci; }
}
__device__ __forceinline__ void s5_sample_unit(Frame& F, int li, int b, int g8) { UNIT_BEGIN(F);
    const int lane = F.lane, w = F.wave, g = g8 * 8 + w, ig = li * S5G + g;
    float* HS = (float*)(F.lds + w * 4096);
    float* YS = HS + 512;
    const bf16_t* PROJ = WSP(bf16_t, WS_PROJ); bf16_t* YMIX = WSP(bf16_t, WS_YMIX);
    LDS_BARRIER();
    const float ar = WSP(float, WS_S5A)[(ig * S5P + lane) * 2], ai = WSP(float, WS_S5A)[(ig * S5P + lane) * 2 + 1];
    const float* h0 = F.in[I_S5ST] + (((size_t)li * DEC_BATCH + b) * S5G + g) * 128 + lane * 2;
    float hr = h0[0], hi = h0[1];
    const bf16_t* Bt = WSP(bf16_t, WS_S5B) + (size_t)ig * 2048;
    for (int t = 0; t < DEC_SEQ; ++t) { const bf16_t* u = PROJ + (size_t)(MP + b * DEC_SEQ + t) * IN_EVEN_PAD + g * 16; float br = 0.f, bi = 0.f;
#pragma unroll
        for (int c = 0; c < 16; ++c) { const float uc = bf2f(u[c]); br += bf2f(Bt[(2 * lane) * 16 + c]) * uc; bi += bf2f(Bt[(2 * lane + 1) * 16 + c]) * uc; }
        const float nr = ar * hr - ai * hi + br, ni = ar * hi + ai * hr + bi; hr = nr; hi = ni;
        HS[t * 128 + 2 * lane] = hr; HS[t * 128 + 2 * lane + 1] = hi; }
    { float* o = F.out + O_S5S + (((size_t)li * DEC_BATCH + b) * S5G + g) * 128 + lane * 2; o[0] = hr; o[1] = hi; }
    WAVE_SYNC();
    { const int t = lane >> 4, c = lane & 15; const bf16_t* Ct = WSP(bf16_t, WS_S5C) + (size_t)ig * 2048 + c * 128; float y = 0.f;
        for (int k = 0; k < 128; ++k) y += bf2f(Ct[k]) * HS[t * 128 + k];
        y += F.in[I_S5D][li * S5W + g * 16 + c] * bf2f(PROJ[(size_t)(MP + b * DEC_SEQ + t) * IN_EVEN_PAD + g * 16 + c]);
        YS[t * 16 + c] = y; }
    WAVE_SYNC();
    { const int t = lane >> 4, e = lane & 15; const float* gw = F.in[I_GLUW] + (size_t)ig * 512; float lin = F.in[I_GLUB][ig * 32 + e], gt = F.in[I_GLUB][ig * 32 + 16 + e];
#pragma unroll
        for (int c = 0; c < 16; ++c) { const float y = YS[t * 16 + c]; lin += y * gw[c * 32 + e]; gt += y * gw[c * 32 + 16 + e]; }
        YMIX[(size_t)(MP + b * DEC_SEQ + t) * MIXE + g * 16 + e] = (bf16_t)f2bf(lin * sigmoidf_(gt)); }
}
__device__ __forceinline__ void conv8(const bf16_t* PROJ, size_t tokbase, int t, int ch0, const float* cw, const float* cb, float (&o)[8]) {
#pragma unroll
    for (int e = 0; e < 8; ++e) o[e] = cb[ch0 + e];
#pragma unroll
    for (int k = 0; k < 4; ++k) { const int tt = t - 3 + k; if (tt >= 0) { const u32x4 v = *(const u32x4*)(PROJ + (tokbase + tt) * IN_EVEN_PAD + 1536 + ch0); const float* wk = cw + k * CONVD + ch0;
            o[0] += wk[0] * bflo(v.x); o[1] += wk[1] * bfhi(v.x); o[2] += wk[2] * bflo(v.y); o[3] += wk[3] * bfhi(v.y); o[4] += wk[4] * bflo(v.z); o[5] += wk[5] * bfhi(v.z); o[6] += wk[6] * bflo(v.w); o[7] += wk[7] * bfhi(v.w); } }
#pragma unroll
    for (int e = 0; e < 8; ++e) o[e] = siluf_(o[e]);
}
__device__ __forceinline__ void conv4x8(const bf16_t* PROJ, size_t tokbase, int t0, int ch0, const float* cw, const float* cb, float (&o)[4][8]) {
#pragma unroll
    for (int e = 0; e < 8; ++e) { const float bias = cb[ch0 + e];
#pragma unroll
        for (int i = 0; i < 4; ++i) o[i][e] = bias; }
#pragma unroll
    for (int rr = 0; rr < 7; ++rr) { const int tt = t0 - 3 + rr; u32x4 v = {0u, 0u, 0u, 0u}; if (tt >= 0) v = *(const u32x4*)(PROJ + (tokbase + tt) * IN_EVEN_PAD + 1536 + ch0);
        const float x[8] = {bflo(v.x), bfhi(v.x), bflo(v.y), bfhi(v.y), bflo(v.z), bfhi(v.z), bflo(v.w), bfhi(v.w)};
#pragma unroll
        for (int k = 0; k < 4; ++k) { const int i = rr - k;
            if (i >= 0 && i < 4) { const float* wk = cw + k * CONVD + ch0;
#pragma unroll
                for (int e = 0; e < 8; ++e) o[i][e] += wk[e] * x[e]; } } }
#pragma unroll
    for (int i = 0; i < 4; ++i)
#pragma unroll
        for (int e = 0; e < 8; ++e) o[i][e] = siluf_(o[i][e]);
}
__device__ __forceinline__ void ssd_local_unit(Frame& F, int li, int b, int c, int G) { UNIT_BEGIN(F);
    constexpr int P = 136, RB = 128 * P * 2;
    bf16_t* Bn = (bf16_t*)F.lds; bf16_t* Cm = (bf16_t*)(F.lds + RB); bf16_t* BT = (bf16_t*)(F.lds + 2 * RB); bf16_t* XT = (bf16_t*)(F.lds + 3 * RB); bf16_t* XdT = XT + 64 * P;
    float* DT = (float*)(F.lds + 3 * RB + 2 * 64 * P * 2); float* AC = DT + 4 * 128;
    const bf16_t* PROJ = WSP(bf16_t, WS_PROJ); bf16_t* XBCA = WSP(bf16_t, WS_XBCA);
    const float* cw = F.in[I_CONVW] + (size_t)li * 4 * CONVD; const float* cb = F.in[I_CONVB] + (size_t)li * CONVD;
    const int tid = F.tid, lane = F.lane, w = F.wave; const size_t tokbase = (size_t)b * SEQ; const int t0 = c * CHUNK;
    LDS_BARRIER();
    for (int it = tid; it < 2 * 16 * 32; it += NT) { const int isC = it >> 9, cc = (it >> 5) & 15, lr = it & 31, ch0 = 1024 + isC * 512 + G * 128 + 8 * cc, l0 = 4 * lr; float o[4][8];
        conv4x8(PROJ, tokbase, t0 + l0, ch0, cw, cb, o);
#pragma unroll
        for (int i = 0; i < 4; ++i) { u32x4 pk; pk.x = pk2(o[i][0], o[i][1]); pk.y = pk2(o[i][2], o[i][3]); pk.z = pk2(o[i][4], o[i][5]); pk.w = pk2(o[i][6], o[i][7]);
            if (isC) { *(u32x4*)(Cm + (l0 + i) * P + 8 * cc) = pk; *(u32x4*)(XBCA + (tokbase + t0 + l0 + i) * CONVD + ch0) = pk; } else *(u32x4*)(Bn + (l0 + i) * P + 8 * cc) = pk; }
        if (!isC) {
#pragma unroll
            for (int e = 0; e < 8; ++e) { u32x2 pk; pk.x = pk2(o[0][e], o[1][e]); pk.y = pk2(o[2][e], o[3][e]); *(u32x2*)(BT + swz(8 * cc + e, l0, P)) = pk; } } }
    if (w < 4) { const int head = 4 * G + w; const float bias = F.in[I_DTB][li * SSDH + head], a = -__expf(F.in[I_ALOG][li * SSDH + head]); const int l0 = 2 * lane;
        const float dt0 = softplusf_(bf2f(PROJ[(tokbase + t0 + l0) * IN_EVEN_PAD + 3584 + head]) + bias), dt1 = softplusf_(bf2f(PROJ[(tokbase + t0 + l0 + 1) * IN_EVEN_PAD + 3584 + head]) + bias);
        const float v0 = dt0 * a, v1 = dt1 * a; float sc = v0 + v1;
#pragma unroll
        for (int d = 1; d < 64; d <<= 1) { const float t = __shfl(sc, lane - d); if (lane >= d) sc += t; }
        const float cs1 = sc, cs0 = sc - v1;
        DT[w * 128 + l0] = dt0; DT[w * 128 + l0 + 1] = dt1; AC[w * 128 + l0] = cs0; AC[w * 128 + l0 + 1] = cs1;
        WSP(float, WS_DTV)[(tokbase + t0 + l0) * 16 + head] = dt0; WSP(float, WS_DTV)[(tokbase + t0 + l0 + 1) * 16 + head] = dt1;
        WSP(float, WS_ACS)[(tokbase + t0 + l0) * 16 + head] = cs0; WSP(float, WS_ACS)[(tokbase + t0 + l0 + 1) * 16 + head] = cs1; }
    if (c == NCH - 1) for (int e = tid; e < 3 * 512; e += NT) { const int k = e / 512, j = e % 512, ch = j < 256 ? G * 256 + j : (j < 384 ? 1024 + G * 128 + (j - 256) : 1536 + G * 128 + (j - 384));
        F.out[O_CONVP + ((size_t)(li * BATCH + b) * 3 + k) * CONVD + ch] = bf2f(PROJ[(tokbase + SEQ - 3 + k) * IN_EVEN_PAD + 1536 + ch]); }
    LDS_BARRIER();
    { f32x16 cbt[2];
#pragma unroll
        for (int q = 0; q < 2; ++q) { const int tile = 2 * w + q, ti = tile >> 2, tj = tile & 3; cbt[q] = Z16; if (tj <= ti) mma32_lds(cbt[q], Cm + 32 * ti * P, P, Bn + 32 * tj * P, P, 128, lane); }
        LDS_BARRIER();
#pragma unroll
        for (int q = 0; q < 2; ++q) { const int tile = 2 * w + q, ti = tile >> 2, tj = tile & 3;
#pragma unroll
            for (int i = 0; i < 16; ++i) Bn[(32 * ti + crow(i, lane >> 5)) * P + 32 * tj + (lane & 31)] = (bf16_t)f2bf_hw(cbt[q][i]); } }
    LDS_BARRIER();
    for (int hh = 0; hh < 4; ++hh) { const int head = 4 * G + hh; const float* dt = DT + hh * 128; const float* ac = AC + hh * 128; const float aclast = ac[127];
        if (tid < 256) { const int cc = tid >> 5, lr = tid & 31, ch0 = head * 64 + 8 * cc, l0 = 4 * lr; float o[4][8]; conv4x8(PROJ, tokbase, t0 + l0, ch0, cw, cb, o); float d1[4], d2[4];
#pragma unroll
            for (int i = 0; i < 4; ++i) { d1[i] = dt[l0 + i]; d2[i] = d1[i] * __expf(aclast - ac[l0 + i]);
                u32x4 pk; pk.x = pk2(o[i][0], o[i][1]); pk.y = pk2(o[i][2], o[i][3]); pk.z = pk2(o[i][4], o[i][5]); pk.w = pk2(o[i][6], o[i][7]); *(u32x4*)(XBCA + (tokbase + t0 + l0 + i) * CONVD + ch0) = pk; }
#pragma unroll
            for (int e = 0; e < 8; ++e) { u32x2 p1, p2;
                p1.x = pk2(o[0][e] * d1[0], o[1][e] * d1[1]); p1.y = pk2(o[2][e] * d1[2], o[3][e] * d1[3]); p2.x = pk2(o[0][e] * d2[0], o[1][e] * d2[1]); p2.y = pk2(o[2][e] * d2[2], o[3][e] * d2[3]);
                *(u32x2*)(XT + swz(8 * cc + e, l0, P)) = p1; *(u32x2*)(XdT + swz(8 * cc + e, l0, P)) = p2; } }
        for (int it = tid; it < 128 * 16; it += NT) { const int l = it >> 4, s0 = 8 * (it & 15); u32x4 pk = {0u, 0u, 0u, 0u};
            if (s0 <= l) { const u32x4 cbv = *(const u32x4*)(Bn + l * P + s0); const float al = ac[l]; float v[8] = {bflo(cbv.x), bfhi(cbv.x), bflo(cbv.y), bfhi(cbv.y), bflo(cbv.z), bfhi(cbv.z), bflo(cbv.w), bfhi(cbv.w)};
#pragma unroll
                for (int e = 0; e < 8; ++e) v[e] = (s0 + e <= l) ? v[e] * __expf(al - ac[s0 + e]) : 0.f;
                pk.x = pk2(v[0], v[1]); pk.y = pk2(v[2], v[3]); pk.z = pk2(v[4], v[5]); pk.w = pk2(v[6], v[7]); }
            *(u32x4*)(Cm + l * P + s0) = pk; }
        LDS_BARRIER();
        { const int ti = w >> 1, pj = w & 1; f32x16 acc = Z16; mma32_lds<false, true>(acc, Cm + 32 * ti * P, P, XT, P, 32 * (ti + 1), lane, 0, 32 * pj);
            float* YD = WSP(float, WS_YD);
#pragma unroll
            for (int i = 0; i < 16; ++i) YD[(tokbase + t0 + 32 * ti + crow(i, lane >> 5)) * DM + head * 64 + 32 * pj + (lane & 31)] = acc[i]; }
        { const int pi = w >> 2, nj = w & 3; f32x16 acc = Z16; mma32_lds<true, true>(acc, XdT, P, BT, P, 128, lane, 32 * pi, 32 * nj);
            float* ST = WSP(float, WS_STL) + (((size_t)(b * NCH + c) * SSDH + head) * 64) * 128;
#pragma unroll
            for (int i = 0; i < 16; ++i) ST[(32 * pi + crow(i, lane >> 5)) * 128 + 32 * nj + (lane & 31)] = acc[i]; }
        LDS_BARRIER();
    }
}
__device__ __forceinline__ void ssd_sample_unit(Frame& F, int li, int b, int G) { UNIT_BEGIN(F);
    float* XS = (float*)F.lds; float* BS = XS + 4 * 256; float* CS = BS + 4 * 128; float* DTS = CS + 4 * 128;
    const bf16_t* PROJ = WSP(bf16_t, WS_PROJ); const int tid = F.tid; const size_t tok0 = (size_t)MP + b * DEC_SEQ;
    const float* cw = F.in[I_CONVW] + (size_t)li * 4 * CONVD; const float* cb = F.in[I_CONVB] + (size_t)li * CONVD; const float* cst = F.in[I_CONVST] + ((size_t)li * DEC_BATCH + b) * 3 * CONVD;
    const int p = tid >> 3, n0 = (tid & 7) * 16; const size_t so = (((size_t)li * DEC_BATCH + b) * SSDH + 4 * G) * 8192 + p * 128 + n0;
    f32x4 h[4][4];
#pragma unroll
    for (int hh = 0; hh < 4; ++hh)
#pragma unroll
        for (int j = 0; j < 4; ++j) h[hh][j] = *(const f32x4*)(F.in[I_SSDST] + so + (size_t)hh * 8192 + 4 * j);
    LDS_BARRIER();
    { const int ch = tid < 256 ? G * 256 + tid : (tid < 384 ? 1024 + G * 128 + (tid - 256) : 1536 + G * 128 + (tid - 384)); float xp[7], wk[4];
#pragma unroll
        for (int k = 0; k < 3; ++k) xp[k] = cst[k * CONVD + ch];
#pragma unroll
        for (int t = 0; t < 4; ++t) xp[3 + t] = bf2f(PROJ[(tok0 + t) * IN_EVEN_PAD + 1536 + ch]);
#pragma unroll
        for (int k = 0; k < 4; ++k) wk[k] = cw[k * CONVD + ch];
        const float bias = cb[ch];
#pragma unroll
        for (int t = 0; t < 4; ++t) { float v = bias;
#pragma unroll
            for (int k = 0; k < 4; ++k) v += wk[k] * xp[t + k];
            v = siluf_(v); if (tid < 256) XS[t * 256 + tid] = v; else if (tid < 384) BS[t * 128 + tid - 256] = v; else CS[t * 128 + tid - 384] = v; } }
    if (tid < 16) { const int hh = tid >> 2, t = tid & 3, head = 4 * G + hh; const float dt = softplusf_(bf2f(PROJ[(tok0 + t) * IN_EVEN_PAD + 3584 + head]) + F.in[I_DTB][li * SSDH + head]); DTS[hh * 4 + t] = dt; DTS[16 + hh * 4 + t] = dt * -__expf(F.in[I_ALOG][li * SSDH + head]); }
    if (G == 0) for (int e = tid; e < 3 * CONVD; e += NT) F.out[O_CONVS + ((size_t)li * DEC_BATCH + b) * 3 * CONVD + e] = bf2f(PROJ[(tok0 + 1 + e / CONVD) * IN_EVEN_PAD + 1536 + e % CONVD]);
    LDS_BARRIER();
#pragma unroll
    for (int hh = 0; hh < 4; ++hh) { const int head = 4 * G + hh; const float dsk = F.in[I_SSDD][li * SSDH + head];
#pragma unroll
        for (int t = 0; t < 4; ++t) { const float dec = __expf(DTS[16 + hh * 4 + t]), xv = XS[t * 256 + hh * 64 + p], xd = DTS[hh * 4 + t] * xv; float y = 0.f;
#pragma unroll
            for (int j = 0; j < 4; ++j) { const f32x4 bv = *(const f32x4*)(BS + t * 128 + n0 + 4 * j), cv = *(const f32x4*)(CS + t * 128 + n0 + 4 * j); f32x4 hv = h[hh][j];
                hv.x = dec * hv.x + xd * bv.x; hv.y = dec * hv.y + xd * bv.y; hv.z = dec * hv.z + xd * bv.z; hv.w = dec * hv.w + xd * bv.w; h[hh][j] = hv;
                y += (cv.x * hv.x + cv.y * hv.y) + (cv.z * hv.z + cv.w * hv.w); }
            y = sum8(y);
            if ((tid & 7) == 0) WSP(float, WS_YD)[(tok0 + t) * DM + head * 64 + p] = y + dsk * xv; }
#pragma unroll
        for (int j = 0; j < 4; ++j) *(f32x4*)(F.out + O_SSDS + so + (size_t)hh * 8192 + 4 * j) = h[hh][j]; }
}
__device__ NOINLINE void ph_even_local(Frame F, int li, int only) { frame_refresh(F);
    constexpr int N1 = BATCH * S5G, N2 = BATCH * NCH * SSDG, N3 = DEC_BATCH * SSDG, N4 = DEC_BATCH * 4;
    if (only == 0 || only == 1) for (int u = F.bid; u < N1; u += F.G) s5_prompt_unit(F, li, u / S5G, u % S5G);
    frame_refresh(F);
    if (only == 0 || only == 2) for (int v = F.bid; v < N2; v += F.G) ssd_local_unit(F, li, v / (NCH * SSDG), (v / SSDG) % NCH, v % SSDG);
    frame_refresh(F);
    if (only == 0 || only == 3) for (int v = F.bid; v < N3; v += F.G) ssd_sample_unit(F, li, v / SSDG, v % SSDG);
    frame_refresh(F);
    if (only == 0 || only == 4) for (int v = F.bid; v < N4; v += F.G) s5_sample_unit(F, li, v >> 2, v & 3);
}
__device__ NOINLINE void ph_ssd_carry(Frame F, int li) { frame_refresh(F);
    const int gt = F.bid * NT + F.tid, GT = F.G * NT;
    for (int e = gt; e < BATCH * SSDH * 64 * 32; e += GT) { const int n4 = e & 31, p = (e >> 5) & 63, head = (e >> 11) & 15, b = e >> 15; f32x4 s = {0.f, 0.f, 0.f, 0.f};
        f32x4 loc[NCH]; float dec[NCH];
#pragma unroll
        for (int c = 0; c < NCH; ++c) { const size_t o = ((((size_t)(b * NCH + c) * SSDH + head) * 64) + p) * 128 + 4 * n4; loc[c] = *(const f32x4*)(WSP(float, WS_STL) + o); dec[c] = WSP(float, WS_ACS)[((size_t)b * SEQ + c * CHUNK + CHUNK - 1) * 16 + head]; }
#pragma unroll
        for (int c = 0; c < NCH; ++c) { const size_t o = ((((size_t)(b * NCH + c) * SSDH + head) * 64) + p) * 128 + 4 * n4;
            u32x2 pk; pk.x = pk2(s.x, s.y); pk.y = pk2(s.z, s.w); *(u32x2*)(WSP(bf16_t, WS_STIN) + o) = pk;
            s = s * __expf(dec[c]) + loc[c]; }
        *(f32x4*)(F.out + O_SSDP + (((size_t)(li * BATCH + b) * SSDH + head) * 64 + p) * 128 + 4 * n4) = s; }
}
__device__ __forceinline__ void ssd_fix_unit(Frame& F, int li, int b, int c, int q4) { UNIT_BEGIN(F);
    constexpr int CP = 520, YP = 1032;
    bf16_t* CL = (bf16_t*)F.lds;
    bf16_t* YO = (bf16_t*)(F.lds + 32 * CP * 2);
    float* RS = (float*)(F.lds + 32 * CP * 2 + 32 * YP * 2);
    const bf16_t* PROJ = WSP(bf16_t, WS_PROJ); const bf16_t* XBCA = WSP(bf16_t, WS_XBCA); bf16_t* YMIX = WSP(bf16_t, WS_YMIX);
    const int tid = F.tid, lane = F.lane, w = F.wave, r = lane & 31, hi = lane >> 5; const size_t tok0 = (size_t)b * SEQ + c * CHUNK + 32 * q4;
    LDS_BARRIER();
    for (int it = tid; it < 32 * 64; it += NT) { const int l = it >> 6, cc = it & 63; *(u32x4*)(CL + l * CP + 8 * cc) = *(const u32x4*)(XBCA + (tok0 + l) * CONVD + 1536 + 8 * cc); }
    LDS_BARRIER();
    {
        const bf16_t* ST = WSP(bf16_t, WS_STIN) + (((size_t)(b * NCH + c) * SSDH + 2 * w) * 64) * 128 + (size_t)r * 128 + 8 * hi;
        bf16x8 bb[2][2][8];
        if (c > 0) {
#pragma unroll
            for (int hq = 0; hq < 2; ++hq)
#pragma unroll
                for (int pj = 0; pj < 2; ++pj)
#pragma unroll
                    for (int k = 0; k < 8; ++k) bb[hq][pj][k] = *(const bf16x8*)(ST + (size_t)hq * 8192 + pj * 4096 + 16 * k); }
#pragma unroll
        for (int hq = 0; hq < 2; ++hq) { const int head = 2 * w + hq, G = head >> 2; f32x16 acc0 = Z16, acc1 = Z16; const bf16_t* ap = CL + r * CP + G * 128 + 8 * hi;
            if (c > 0) {
#pragma unroll
                for (int k = 0; k < 8; ++k) { const bf16x8 a = *(const bf16x8*)(ap + 16 * k); acc0 = MFMA32(a, bb[hq][0][k], acc0); acc1 = MFMA32(a, bb[hq][1][k], acc1); } }
#pragma unroll
            for (int i = 0; i < 16; ++i) { YO[crow(i, hi) * YP + head * 64 + r] = (bf16_t)f2bf(acc0[i]); YO[crow(i, hi) * YP + head * 64 + 32 + r] = (bf16_t)f2bf(acc1[i]); } } }
    LDS_BARRIER();
    { const int l = tid >> 4; const size_t tok = tok0 + l; float ss = 0.f;
#pragma unroll
        for (int q0 = 0; q0 < 8; q0 += 4) { u32x4 xx[4], zz[4]; f32x4 d0[4], d1[4]; float ea[4], dsk[4];
#pragma unroll
            for (int j = 0; j < 4; ++j) { const int cc = (tid & 15) + 16 * (q0 + j), ch = 8 * cc, head = cc >> 3; ea[j] = WSP(float, WS_ACS)[tok * 16 + head]; dsk[j] = F.in[I_SSDD][li * SSDH + head];
                xx[j] = *(const u32x4*)(XBCA + tok * CONVD + ch); zz[j] = *(const u32x4*)(PROJ + tok * IN_EVEN_PAD + 512 + ch);
                d0[j] = *(const f32x4*)(WSP(float, WS_YD) + tok * DM + ch); d1[j] = *(const f32x4*)(WSP(float, WS_YD) + tok * DM + ch + 4); }
#pragma unroll
            for (int j = 0; j < 4; ++j) { const int cc = (tid & 15) + 16 * (q0 + j), ch = 8 * cc; const float e_ = __expf(ea[j]), dk = dsk[j]; const u32x4 yo = *(const u32x4*)(YO + l * YP + ch); float v[8];
                v[0] = (bflo(yo.x) * e_ + d0[j].x + dk * bflo(xx[j].x)) * siluf_(bflo(zz[j].x)); v[1] = (bfhi(yo.x) * e_ + d0[j].y + dk * bfhi(xx[j].x)) * siluf_(bfhi(zz[j].x));
                v[2] = (bflo(yo.y) * e_ + d0[j].z + dk * bflo(xx[j].y)) * siluf_(bflo(zz[j].y)); v[3] = (bfhi(yo.y) * e_ + d0[j].w + dk * bfhi(xx[j].y)) * siluf_(bfhi(zz[j].y));
                v[4] = (bflo(yo.z) * e_ + d1[j].x + dk * bflo(xx[j].z)) * siluf_(bflo(zz[j].z)); v[5] = (bfhi(yo.z) * e_ + d1[j].y + dk * bfhi(xx[j].z)) * siluf_(bfhi(zz[j].z));
                v[6] = (bflo(yo.w) * e_ + d1[j].z + dk * bflo(xx[j].w)) * siluf_(bflo(zz[j].w)); v[7] = (bfhi(yo.w) * e_ + d1[j].w + dk * bfhi(xx[j].w)) * siluf_(bfhi(zz[j].w));
#pragma unroll
                for (int e = 0; e < 8; ++e) ss += v[e] * v[e];
                u32x4 pk; pk.x = pk2(v[0], v[1]); pk.y = pk2(v[2], v[3]); pk.z = pk2(v[4], v[5]); pk.w = pk2(v[6], v[7]); *(u32x4*)(YO + l * YP + ch) = pk; } }
        ss += __shfl_xor(ss, 1); ss += __shfl_xor(ss, 2); ss += __shfl_xor(ss, 4); ss += __shfl_xor(ss, 8);
        if ((tid & 15) == 0) RS[l] = 1.f / sqrtf(ss * (1.f / DM) + EPS); }
    LDS_BARRIER();
    { const int l = tid >> 4; const size_t tok = tok0 + l; const float rs = RS[l];
        for (int q = 0; q < 8; ++q) { const int cc = (tid & 15) + 16 * q, ch = 8 * cc; const u32x4 y = *(const u32x4*)(YO + l * YP + ch);
            const f32x4 g0 = *(const f32x4*)(F.in[I_SSDNORM] + li * DM + ch), g1 = *(const f32x4*)(F.in[I_SSDNORM] + li * DM + ch + 4);
            u32x4 pk; pk.x = pk2(bflo(y.x) * rs * g0.x, bfhi(y.x) * rs * g0.y); pk.y = pk2(bflo(y.y) * rs * g0.z, bfhi(y.y) * rs * g0.w); pk.z = pk2(bflo(y.z) * rs * g1.x, bfhi(y.z) * rs * g1.y); pk.w = pk2(bflo(y.w) * rs * g1.z, bfhi(y.w) * rs * g1.w);
            *(u32x4*)(YMIX + tok * MIXE + 512 + ch) = pk; } }
}
__device__ NOINLINE void ph_ssd_fix(Frame F, int li) { frame_refresh(F);
    constexpr int NU = MP / 32;
    for (int u = F.bid; u < NU; u += F.G) { const int q4 = u & 3, c = (u >> 2) % NCH, b = u / (4 * NCH); ssd_fix_unit(F, li, b, c, q4); }
    const bf16_t* PROJ = WSP(bf16_t, WS_PROJ); bf16_t* YMIX = WSP(bf16_t, WS_YMIX);
    for (int m = MP + F.gw; m < MT; m += F.NGW) { float v[16]; float s = 0.f;
#pragma unroll
        for (int j = 0; j < 16; ++j) { const int ch = F.lane + 64 * j; v[j] = WSP(float, WS_YD)[(size_t)m * DM + ch] * siluf_(bf2f(PROJ[(size_t)m * IN_EVEN_PAD + 512 + ch])); s += v[j] * v[j]; }
        const float rs = 1.f / sqrtf(wave_sum(s) * (1.f / DM) + EPS);
#pragma unroll
        for (int j = 0; j < 16; ++j) { const int ch = F.lane + 64 * j; YMIX[(size_t)m * MIXE + 512 + ch] = (bf16_t)f2bf(v[j] * rs * F.in[I_SSDNORM][li * DM + ch]); } }
}
constexpr int CMPROW_S0 = BATCH * NCHK_P * 2;
__device__ NOINLINE void ph_odd_rope(Frame F, int li, bool ident, int only) { frame_refresh(F);
    bf16_t* PROJ = WSP(bf16_t, WS_PROJ); bf16_t* CMPA = WSP(bf16_t, WS_CMPA);
    const int tid = F.tid;
    constexpr int NU_P = MP / 16, NU_S = MS / 16, NU_C = DEC_BATCH * NPAGES;
    constexpr int NU_T = NU_P + NU_S;
    auto item = [&](int u, int it, size_t& tok, int& pos, int& col, bool& rot, bool& isq, int& br, int& iskv, int& g, int& qr, int& tl) { const bool smp = u >= NU_P; const size_t tok0 = smp ? (size_t)MP + (size_t)(u - NU_P) * 16 : (size_t)u * 16;
        tl = it >> 6; const int j = it & 63; tok = tok0 + tl; pos = smp ? PAST + (int)((tok - MP) % DEC_SEQ) : (int)(tok % SEQ);
        isq = j < 16; const int kvi = j - 16, vec = kvi >> 2; qr = kvi & 3; br = vec >> 2; iskv = (vec >> 1) & 1; g = vec & 1;
        col = isq ? j * 64 : 1024 + br * 256 + iskv * 128 + g * 64 + qr * 16; rot = isq || (iskv == 0 && qr == 0); };
    if (only == 0 || only == 1) for (int u0 = F.bid; u0 < NU_T; u0 += 2 * F.G) { u32x4 a[4], c[4]; f32x4 tb[4][4];
#pragma unroll
        for (int q = 0; q < 4; ++q) { const int u = u0 + (q >> 1) * F.G; if (u < NU_T) { size_t tok; int pos, col, br, iskv, g, qr, tl; bool rot, isq; item(u, tid + NT * (q & 1), tok, pos, col, rot, isq, br, iskv, g, qr, tl);
                const u32x4* p = (const u32x4*)(PROJ + tok * IN_ODD_PAD + col); a[q] = p[0]; c[q] = p[1];
                if (rot) { const f32x4* t4 = (const f32x4*)(WSP(float, WS_ROPE) + (size_t)pos * 16); tb[q][0] = t4[0]; tb[q][1] = t4[1]; tb[q][2] = t4[2]; tb[q][3] = t4[3]; } } }
#pragma unroll
        for (int q = 0; q < 4; ++q) { const int u = u0 + (q >> 1) * F.G; if (u < NU_T) { size_t tok; int pos, col, br, iskv, g, qr, tl; bool rot, isq; item(u, tid + NT * (q & 1), tok, pos, col, rot, isq, br, iskv, g, qr, tl);
                const bool smp = u >= NU_P; u32x4 av = a[q], cv = c[q];
                if (rot) { f32x4 c0 = tb[q][0], c1 = tb[q][1], s0 = tb[q][2], s1 = tb[q][3];
                    if (ident) { c0 = (f32x4){1.f, 1.f, 1.f, 1.f}; c1 = c0; s0 = (f32x4){0.f, 0.f, 0.f, 0.f}; s1 = s0; }
                    const float cs[8] = {c0.x, c0.y, c0.z, c0.w, c1.x, c1.y, c1.z, c1.w}, sn[8] = {s0.x, s0.y, s0.z, s0.w, s1.x, s1.y, s1.z, s1.w};
                    const float x1[8] = {bflo(av.x), bfhi(av.x), bflo(av.y), bfhi(av.y), bflo(av.z), bfhi(av.z), bflo(av.w), bfhi(av.w)}, x2[8] = {bflo(cv.x), bfhi(cv.x), bflo(cv.y), bfhi(cv.y), bflo(cv.z), bfhi(cv.z), bflo(cv.w), bfhi(cv.w)};
                    av.x = pk2(x1[0] * cs[0] - x2[0] * sn[0], x1[1] * cs[1] - x2[1] * sn[1]); av.y = pk2(x1[2] * cs[2] - x2[2] * sn[2], x1[3] * cs[3] - x2[3] * sn[3]);
                    av.z = pk2(x1[4] * cs[4] - x2[4] * sn[4], x1[5] * cs[5] - x2[5] * sn[5]); av.w = pk2(x1[6] * cs[6] - x2[6] * sn[6], x1[7] * cs[7] - x2[7] * sn[7]);
                    cv.x = pk2(x2[0] * cs[0] + x1[0] * sn[0], x2[1] * cs[1] + x1[1] * sn[1]); cv.y = pk2(x2[2] * cs[2] + x1[2] * sn[2], x2[3] * cs[3] + x1[3] * sn[3]);
                    cv.z = pk2(x2[4] * cs[4] + x1[4] * sn[4], x2[5] * cs[5] + x1[5] * sn[5]); cv.w = pk2(x2[6] * cs[6] + x1[6] * sn[6], x2[7] * cs[7] + x1[7] * sn[7]);
                    u32x4* p = (u32x4*)(PROJ + tok * IN_ODD_PAD + col); p[0] = av; p[1] = cv; }
                if (!isq) { const int jo = iskv * 128 + g * 64 + qr * 16; float* dst = nullptr;
                    if (!smp) { const int b = (int)(tok / SEQ), t = (int)(tok % SEQ);
                        if (br == 0) dst = F.out + O_CMPP + ((size_t)li * MP + tok) * 256 + jo; else if (br == 1) dst = F.out + O_SELP + ((size_t)li * MP + tok) * 256 + jo;
                        else if (t >= SEQ - WKEEP_P) dst = F.out + O_WINP + (((size_t)li * BATCH + b) * WKEEP_P + (t - (SEQ - WKEEP_P))) * 256 + jo;
                    } else { const size_t ts = tok - MP; const int b = (int)(ts / DEC_SEQ), t = (int)(ts % DEC_SEQ);
                        if (br == 0) dst = F.out + O_CMPS + ((size_t)li * MS + ts) * 256 + jo; else if (br == 1) dst = F.out + O_SELS + ((size_t)li * MS + ts) * 256 + jo;
                        else dst = F.out + O_WINS + (((size_t)li * DEC_BATCH + b) * WKEEP_S + (WKEEP_S - DEC_SEQ + t)) * 256 + jo; }
                    if (dst) { ((f32x4*)dst)[0] = (f32x4){bflo(av.x), bfhi(av.x), bflo(av.y), bfhi(av.y)}; ((f32x4*)dst)[1] = (f32x4){bflo(av.z), bfhi(av.z), bflo(av.w), bfhi(av.w)};
                        ((f32x4*)dst)[2] = (f32x4){bflo(cv.x), bfhi(cv.x), bflo(cv.y), bfhi(cv.y)}; ((f32x4*)dst)[3] = (f32x4){bflo(cv.z), bfhi(cv.z), bflo(cv.w), bfhi(cv.w)}; }
                    if (!smp && br == 0) { u32x4* cd = (u32x4*)(CMPA + ((size_t)iskv * CMPROWS_PAD + (size_t)u * 2 + g) * 1024 + tl * 64 + qr * 16); cd[0] = av; cd[1] = cv; } } } }
    }
    if (only == 0 || only == 2) for (int v = F.bid; v < NU_C; v += F.G) { const int b = v / NPAGES, pg = v % NPAGES; const int page = ((const int*)F.in[I_PT])[b * NPAGES + pg];
        const int pos = tid >> 5, kv = (tid >> 4) & 1, g = (tid >> 3) & 1, c8 = tid & 7;
        const float* src = F.in[I_CCMP] + (((size_t)li * NPOOL + page) * PAGE + pos) * 256 + kv * 128 + g * 64 + 8 * c8; f32x4 va[8], vc[8];
#pragma unroll
        for (int j8 = 0; j8 < 8; ++j8) { va[j8] = ((const f32x4*)(src + (size_t)j8 * 16 * 256))[0]; vc[j8] = ((const f32x4*)(src + (size_t)j8 * 16 * 256))[1]; }
#pragma unroll
        for (int j8 = 0; j8 < 8; ++j8) { const size_t R = (size_t)CMPROW_S0 + ((size_t)b * NCHK_S + pg * 8 + j8) * 2 + g;
            u32x4 pk; pk.x = pk2(va[j8].x, va[j8].y); pk.y = pk2(va[j8].z, va[j8].w); pk.z = pk2(vc[j8].x, vc[j8].y); pk.w = pk2(vc[j8].z, vc[j8].w);
            *(u32x4*)(CMPA + ((size_t)kv * CMPROWS_PAD + R) * 1024 + pos * 64 + 8 * c8) = pk; }
    }
}
__device__ NOINLINE void ph_win_copy(Frame F, int li, int blk, int nblk) { frame_refresh(F);
    const unsigned gt = (unsigned)(blk * NT + F.tid), GT = (unsigned)(nblk * NT); constexpr unsigned NOLD = WKEEP_S - DEC_SEQ;
    constexpr unsigned NIT = (unsigned)DEC_BATCH * NOLD * 64; static_assert((size_t)DEC_BATCH * NOLD * 64 < (1ull << 31), "32-bit item index");
    const float* srcb = F.in[I_WINST] + ((size_t)li * DEC_BATCH * WBUF + (WBUF + DEC_SEQ - WKEEP_S)) * 256; float* dstb = F.out + O_WINS + (size_t)li * DEC_BATCH * WKEEP_S * 256;
    for (unsigned e0 = gt; e0 < NIT; e0 += 8u * GT) { f32x4 v[8];
#pragma unroll
        for (int k = 0; k < 8; ++k) { const unsigned e = e0 + (unsigned)k * GT; if (e < NIT) { const unsigned c4 = e & 63u, rb = e >> 6, b = rb / NOLD, r = rb - b * NOLD; v[k] = *(const f32x4*)(srcb + ((size_t)b * WBUF + r) * 256 + 4 * c4); } }
#pragma unroll
        for (int k = 0; k < 8; ++k) { const unsigned e = e0 + (unsigned)k * GT; if (e < NIT) { const unsigned c4 = e & 63u, rb = e >> 6, b = rb / NOLD, r = rb - b * NOLD; *(f32x4*)(dstb + ((size_t)b * WKEEP_S + r) * 256 + 4 * c4) = v[k]; } } }
}
__device__ NOINLINE void ph_cmp_finish(Frame F, int li) { frame_refresh(F);
    constexpr int HP = 136;
    bf16_t* HID = (bf16_t*)F.lds; bf16_t* W2T = HID + 128 * HP; float* CB = (float*)(W2T + 64 * HP);
    const bf16_t* AB = WSP(bf16_t, WS_CMPAB); bf16_t* KC = WSP(bf16_t, WS_KC); const int tid = F.tid, lane = F.lane, w = F.wave;
    constexpr int NU = 2 * (BATCH + DEC_BATCH) * 2;
    for (int u = F.bid; u < NU; u += F.G) { const int g = u & 1, seqa = (u >> 1) % (BATCH + DEC_BATCH), kv = u / (2 * (BATCH + DEC_BATCH));
        const bool smp = seqa >= BATCH; const int ncmp = smp ? NCMP_S : NCMP_P; const int Rb0 = smp ? CMPROW_S0 + (seqa - BATCH) * NCHK_S * 2 + g : seqa * NCHK_P * 2 + g;
        LDS_BARRIER();
        for (int e = tid; e < 128 * 64; e += NT) { const int n = e >> 6, d = e & 63; W2T[d * HP + n] = (bf16_t)f2bf(F.in[I_CW2][((size_t)(li * 2 + kv) * 128 + n) * 64 + d]); }
        if (tid < 128) { float sb = 0.f; for (int q = 0; q < 32; ++q) sb += WSP(float, WS_CBIAS)[((size_t)(li * 2 + kv) * 32 + q) * 128 + tid]; CB[tid] = sb; }
        LDS_BARRIER();
        for (int it = tid; it < 128 * 16; it += NT) { const int i = it >> 4, c8 = it & 15; u32x4 pk = {0u, 0u, 0u, 0u};
            if (i < ncmp) { const u32x4 a = *(const u32x4*)(AB + ((size_t)kv * CMPROWS_PAD + Rb0 + 2 * i) * 256 + 8 * c8), bb = *(const u32x4*)(AB + ((size_t)kv * CMPROWS_PAD + Rb0 + 2 * i + 2) * 256 + 128 + 8 * c8);
                const float* cb = CB + 8 * c8;
                pk.x = pk2(siluf_(bflo(a.x) + bflo(bb.x) + cb[0]), siluf_(bfhi(a.x) + bfhi(bb.x) + cb[1])); pk.y = pk2(siluf_(bflo(a.y) + bflo(bb.y) + cb[2]), siluf_(bfhi(a.y) + bfhi(bb.y) + cb[3]));
                pk.z = pk2(siluf_(bflo(a.z) + bflo(bb.z) + cb[4]), siluf_(bfhi(a.z) + bfhi(bb.z) + cb[5])); pk.w = pk2(siluf_(bflo(a.w) + bflo(bb.w) + cb[6]), siluf_(bfhi(a.w) + bfhi(bb.w) + cb[7])); }
            *(u32x4*)(HID + i * HP + 8 * c8) = pk; }
        LDS_BARRIER();
        { const int ti = w >> 1, tj = w & 1; f32x16 acc = Z16; mma32_lds(acc, HID + 32 * ti * HP, HP, W2T + 32 * tj * HP, HP, 128, lane);
#pragma unroll
            for (int q = 0; q < 16; ++q) { const int i = 32 * ti + crow(q, lane >> 5); if (i < ncmp) KC[(((size_t)kv * (BATCH + DEC_BATCH) + seqa) * 128 + i) * 128 + g * 64 + 32 * tj + (lane & 31)] = (bf16_t)f2bf(acc[q]); } }
    }
}
constexpr float ATT_SCALE = 0.125f, NEGB = -1e30f;
__device__ __forceinline__ int vtoff(int d, int pc, int VP, int xm) { return d * VP + ((((pc >> 3) ^ ((d >> 3) & xm)) << 3) | (pc & 7)); }
__device__ __forceinline__ int vperm(int key) { const int k16 = key & 15; return (key & ~15) | (8 * ((k16 >> 2) & 1) + 4 * (k16 >> 3) + (k16 & 3)); }
__device__ __forceinline__ bf16x8 packp(const f32x16& p, int s2) { u32x4 w; w.x = pk2(p[8 * s2], p[8 * s2 + 1]); w.y = pk2(p[8 * s2 + 2], p[8 * s2 + 3]); w.z = pk2(p[8 * s2 + 4], p[8 * s2 + 5]); w.w = pk2(p[8 * s2 + 6], p[8 * s2 + 7]); return __builtin_bit_cast(bf16x8, w); }
constexpr float LOG2E = 1.4426950408889634f, MINIT = -1e29f;
template <class MaskF>
__device__ __forceinline__ void attn_sub32(const bf16_t* Ks, int KP, const bf16_t* VT, int VP, int cg0  , int xm  , const bf16x8 (&qf)[4], float& m, float& l, f32x16 (&o)[2], int lane, bool full, MaskF mask) {
    const int r = lane & 31, hi = lane >> 5; f32x16 s = Z16;
#pragma unroll
    for (int ks = 0; ks < 4; ++ks) { const bf16x8 a = *(const bf16x8*)(Ks + r * KP + 16 * ks + 8 * hi); s = MFMA32(a, qf[ks], s); }
    if (!full) {
#pragma unroll
        for (int i = 0; i < 16; ++i) s[i] = mask(crow(i, hi)) ? s[i] : NEGB; }
#pragma unroll
    for (int i = 0; i < 16; i += 2) { const f32x2 a = (f32x2){s[i], s[i + 1]} * (f32x2){LOG2E, LOG2E}; s[i] = a.x; s[i + 1] = a.y; }
    float mx = fmaxf(fmaxf(s[0], s[1]), s[2]);
#pragma unroll
    for (int i = 3; i < 15; i += 2) mx = fmaxf(fmaxf(mx, s[i]), s[i + 1]);
    mx = fmaxf(mx, s[15]); mx = fmaxf(mx, __shfl_xor(mx, 32));
    const float mn = fmaxf(m, mx);
    { const float alpha = EXP2F(m - mn); l *= alpha; o[0] = o[0] * alpha; o[1] = o[1] * alpha; m = mn; }
    f32x2 ps2 = {0.f, 0.f};
#pragma unroll
    for (int i = 0; i < 16; i += 2) { const f32x2 t = (f32x2){s[i], s[i + 1]} - (f32x2){mn, mn}; const f32x2 p = {EXP2F(t.x), EXP2F(t.y)}; s[i] = p.x; s[i + 1] = p.y; ps2 += p; }
    l += ps2.x + ps2.y;
    const bf16x8 p0 = packp(s, 0), p1 = packp(s, 1);
#pragma unroll
    for (int dt = 0; dt < 2; ++dt) { const int d = 32 * dt + r, f = (d >> 3) & xm; const bf16_t* vp = VT + d * VP;
        o[dt] = MFMA32(*(const bf16x8*)(vp + (((cg0 + hi) ^ f) << 3)), p0, o[dt]); o[dt] = MFMA32(*(const bf16x8*)(vp + (((cg0 + 2 + hi) ^ f) << 3)), p1, o[dt]); }
}
template <class MaskF>
__device__ __forceinline__ void attn_tile64(const bf16_t* KB, const bf16_t* VB, const bf16x8 (&qf)[4], float& m, float& l, f32x16 (&o)[2], int lane, bool full0, bool full1, MaskF mask  ) {
    constexpr int KP = 72, VP = 72; const int r = lane & 31, hi = lane >> 5;
    bf16x8 kf[8];
#pragma unroll
    for (int q = 0; q < 8; ++q) kf[q] = *(const bf16x8*)(KB + (32 * (q >> 2) + r) * KP + 16 * (q & 3) + 8 * hi);
    f32x16 s0 = Z16, s1 = Z16;
#pragma unroll
    for (int ks = 0; ks < 4; ++ks) { s0 = MFMA32(kf[ks], qf[ks], s0); s1 = MFMA32(kf[4 + ks], qf[ks], s1); }
    if (!full0) {
#pragma unroll
        for (int i = 0; i < 16; ++i) s0[i] = mask(0, crow(i, hi)) ? s0[i] : NEGB; }
    if (!full1) {
#pragma unroll
        for (int i = 0; i < 16; ++i) s1[i] = mask(1, crow(i, hi)) ? s1[i] : NEGB; }
#pragma unroll
    for (int i = 0; i < 16; i += 2) { const f32x2 a = (f32x2){s0[i], s0[i + 1]} * (f32x2){LOG2E, LOG2E}, c = (f32x2){s1[i], s1[i + 1]} * (f32x2){LOG2E, LOG2E}; s0[i] = a.x; s0[i + 1] = a.y; s1[i] = c.x; s1[i + 1] = c.y; }
    float mx = fmaxf(fmaxf(s0[0], s1[0]), s0[1]);
#pragma unroll
    for (int i = 1; i < 15; ++i) mx = fmaxf(fmaxf(mx, s1[i]), s0[i + 1]);
    mx = fmaxf(mx, s1[15]); mx = fmaxf(mx, __shfl_xor(mx, 32));
    const float mn = fmaxf(m, mx);
    { const float alpha = EXP2F(m - mn); l *= alpha; o[0] = o[0] * alpha; o[1] = o[1] * alpha; m = mn; }
    f32x2 ps2 = {0.f, 0.f};
#pragma unroll
    for (int i = 0; i < 16; i += 2) { const f32x2 t0 = (f32x2){s0[i], s0[i + 1]} - (f32x2){mn, mn}, t1 = (f32x2){s1[i], s1[i + 1]} - (f32x2){mn, mn};
        const f32x2 p0 = {EXP2F(t0.x), EXP2F(t0.y)}, p1 = {EXP2F(t1.x), EXP2F(t1.y)}; s0[i] = p0.x; s0[i + 1] = p0.y; s1[i] = p1.x; s1[i + 1] = p1.y; ps2 += p0; ps2 += p1; }
    l += ps2.x + ps2.y;
    const bf16x8 p00 = packp(s0, 0), p01 = packp(s0, 1), p10 = packp(s1, 0), p11 = packp(s1, 1);
#pragma unroll
    for (int dt = 0; dt < 2; ++dt) { const int d = 32 * dt + r, f = (d >> 3) & 7; const bf16_t* vp = VB + d * VP;
        const bf16x8 v0 = *(const bf16x8*)(vp + (((0 + hi) ^ f) << 3)), v1 = *(const bf16x8*)(vp + (((2 + hi) ^ f) << 3)), v2 = *(const bf16x8*)(vp + (((4 + hi) ^ f) << 3)), v3 = *(const bf16x8*)(vp + (((6 + hi) ^ f) << 3));
        o[dt] = MFMA32(v0, p00, o[dt]); o[dt] = MFMA32(v1, p01, o[dt]); o[dt] = MFMA32(v2, p10, o[dt]); o[dt] = MFMA32(v3, p11, o[dt]); }
}
__device__ __forceinline__ void scale_q(bf16x8 (&qf)[4]) {
#pragma unroll
    for (int ks = 0; ks < 4; ++ks) { u32x4 w = __builtin_bit_cast(u32x4, qf[ks]);
        w.x = pk2(bflo(w.x) * ATT_SCALE, bfhi(w.x) * ATT_SCALE); w.y = pk2(bflo(w.y) * ATT_SCALE, bfhi(w.y) * ATT_SCALE); w.z = pk2(bflo(w.z) * ATT_SCALE, bfhi(w.z) * ATT_SCALE); w.w = pk2(bflo(w.w) * ATT_SCALE, bfhi(w.w) * ATT_SCALE);
        qf[ks] = __builtin_bit_cast(bf16x8, w); }
}
constexpr int KTP = 72, VTP = 136, A_KT = 0, A_VT = A_KT + 128 * KTP * 2, A_SHARED_END = 2 * 18432;
constexpr int PKP = 72, PVP = 40, A_PRIV = 0, PRIV_BYTES = 32 * PKP * 2 + 64 * PVP * 2, A_PRIV_END = A_PRIV + 8 * PRIV_BYTES;
constexpr int A_PS = (A_PRIV_END > A_SHARED_END ? A_PRIV_END : A_SHARED_END), A_SC = A_PS + 32 * 128 * 4, A_SM = A_SC + 32 * 64 * 4, A_TOT = A_SM + 512, A_GT = A_TOT + 32 * 64 * 4, A_END = A_GT + 512;
static_assert(A_END <= LDS_MISC && 8 * 32 * 66 * 4 <= A_PS, "attention LDS map");
template <class RowF> __device__ __forceinline__ void stage_kv_bf16(Frame& F, int nk, RowF rowfn) {
    bf16_t* KT = (bf16_t*)(F.lds + A_KT); bf16_t* VT = (bf16_t*)(F.lds + A_VT);
    for (int it = F.tid; it < nk * 8; it += NT) { const int key = it >> 3, c = it & 7; const bf16_t* kp; const bf16_t* vp; rowfn(key, kp, vp);
        u32x4 kk = {0u, 0u, 0u, 0u}, vv = {0u, 0u, 0u, 0u}; if (kp) { kk = *(const u32x4*)(kp + 8 * c); vv = *(const u32x4*)(vp + 8 * c); }
        *(u32x4*)(KT + key * KTP + 8 * c) = kk; const int pc = vperm(key); bf16_t* vt = VT + vtoff(8 * c, pc, VTP, 7);
        vt[0] = (bf16_t)(vv.x & 0xffffu); vt[VTP] = (bf16_t)(vv.x >> 16); vt[2 * VTP] = (bf16_t)(vv.y & 0xffffu); vt[3 * VTP] = (bf16_t)(vv.y >> 16);
        vt[4 * VTP] = (bf16_t)(vv.z & 0xffffu); vt[5 * VTP] = (bf16_t)(vv.z >> 16); vt[6 * VTP] = (bf16_t)(vv.w & 0xffffu); vt[7 * VTP] = (bf16_t)(vv.w >> 16); }
}
__device__ __forceinline__ void attn_cmp(Frame& F, const bf16x8 (&qf)[4], int pos, int ncmp, int ps_row, int imax_wave, f32x16 (&o)[2]) {
    const bf16_t* KT = (const bf16_t*)(F.lds + A_KT); const bf16_t* VT = (const bf16_t*)(F.lds + A_VT); float* PS = (float*)(F.lds + A_PS);
    const int lane = F.lane, r = lane & 31, hi = lane >> 5; int imax = pos >= 31 ? ((pos - 31) >> 4) : -1; if (imax > ncmp - 1) imax = ncmp - 1;
    constexpr int NSUB = ((NCMP_P > NCMP_S ? NCMP_P : NCMP_S) + 31) / 32;
    const int nsub = imax_wave < 0 ? 0 : ((imax_wave >> 5) + 1 < NSUB ? (imax_wave >> 5) + 1 : NSUB);
    float mx = MINIT, sum = 0.f;
    for (int sb = 0; sb < nsub; ++sb) { f32x16 s = Z16;
#pragma unroll
        for (int ks = 0; ks < 4; ++ks) { const bf16x8 a = *(const bf16x8*)(KT + (32 * sb + r) * KTP + 16 * ks + 8 * hi); s = MFMA32(a, qf[ks], s); }
        float tm = NEGB;
#pragma unroll
        for (int i = 0; i < 16; ++i) { const float v = (32 * sb + crow(i, hi) <= imax) ? s[i] : NEGB; s[i] = v; tm = fmaxf(tm, v); }
        const float mn = fmaxf(mx, tm), nb = -mn * LOG2E; float ps = 0.f;
#pragma unroll
        for (int i = 0; i < 16; ++i) ps += EXP2F(fmaf(s[i], LOG2E, nb));
        sum = sum * EXP2F((mx - mn) * LOG2E) + ps; mx = mn; }
    { const float mo = __shfl_xor(mx, 32), so = __shfl_xor(sum, 32), M = fmaxf(mx, mo); sum = sum * EXP2F((mx - M) * LOG2E) + so * EXP2F((mo - M) * LOG2E); mx = M; }
    const float inv = sum > 0.f ? 1.f / sum : 0.f, nb = -mx * LOG2E;
    o[0] = Z16; o[1] = Z16;
    for (int sb = 0; sb < NSUB; ++sb) {
        if (sb < nsub) { f32x16 s = Z16;
#pragma unroll
            for (int ks = 0; ks < 4; ++ks) { const bf16x8 a = *(const bf16x8*)(KT + (32 * sb + r) * KTP + 16 * ks + 8 * hi); s = MFMA32(a, qf[ks], s); }
#pragma unroll
            for (int i = 0; i < 16; ++i) s[i] = (32 * sb + crow(i, hi) <= imax) ? EXP2F(fmaf(s[i], LOG2E, nb)) * inv : 0.f;
            const bf16x8 p0 = packp(s, 0), p1 = packp(s, 1);
#pragma unroll
            for (int dt = 0; dt < 2; ++dt) { const int d = 32 * dt + r, f = (d >> 3) & 7; const bf16_t* vp = VT + d * VTP; o[dt] = MFMA32(*(const bf16x8*)(vp + (((4 * sb + hi) ^ f) << 3)), p0, o[dt]); o[dt] = MFMA32(*(const bf16x8*)(vp + (((4 * sb + 2 + hi) ^ f) << 3)), p1, o[dt]); }
#pragma unroll
            for (int i = 0; i < 16; ++i) { const float v = sum8(s[i]); if ((r & 7) == 0) PS[ps_row * 128 + 32 * sb + crow(i, hi)] = v; }
        } else if ((r & 7) == 0) {
#pragma unroll
            for (int i = 0; i < 16; ++i) PS[ps_row * 128 + 32 * sb + crow(i, hi)] = 0.f; } }
}
__device__ __forceinline__ void attn_topk(Frame& F, int ntok, int pos0, int ncmp, int nslc) {
    const float* PS = (const float*)(F.lds + A_PS); float* SC = (float*)(F.lds + A_SC); unsigned* SM = (unsigned*)(F.lds + A_SM);
    const int kk = TOPK < nslc ? TOPK : nslc;
    for (int e = F.tid; e < ntok * 64; e += NT) { const int tl = e >> 6, j = e & 63; if (j < 2) SM[tl * 2 + j] = 0u; if (tl == 0 && j < 2) SM[64 + j] = 0u;
        if (j < nslc) { const int pos = pos0 + tl, qb = pos >> 6; float imp = 0.f;
            for (int ci = 4 * j - 1; ci <= 4 * j + 3; ++ci) if (ci >= 0 && ci < ncmp) imp += PS[tl * 128 + ci];
            const bool valid = j * 64 <= pos, forced = (j == 0) || (j == qb) || (j == qb - 1);
            SC[tl * 64 + j] = valid ? imp + (forced ? 1e4f : 0.f) : NEGB; } }
    LDS_BARRIER();
    for (int e = F.tid; e < ntok * 64; e += NT) { const int tl = e >> 6, j = e & 63;
        if (j < nslc) { const float v = SC[tl * 64 + j]; int rank = 0;
            for (int j2 = 0; j2 < nslc; ++j2) { const float v2 = SC[tl * 64 + j2]; rank += (v2 > v || (v2 == v && j2 < j)) ? 1 : 0; }
            if (rank < kk) { atomicOr(&SM[tl * 2 + (j >> 5)], 1u << (j & 31)); atomicOr(&SM[64 + (j >> 5)], 1u << (j & 31)); } } }
    LDS_BARRIER();
}
__device__ __forceinline__ void store_o(bf16_t* dst, const f32x16 (&t)[2], int hi) {
#pragma unroll
    for (int dt = 0; dt < 2; ++dt)
#pragma unroll
        for (int q = 0; q < 4; ++q) { u32x2 w; w.x = pk2(t[dt][4 * q], t[dt][4 * q + 1]); w.y = pk2(t[dt][4 * q + 2], t[dt][4 * q + 3]); *(u32x2*)(dst + 32 * dt + 8 * q + 4 * hi) = w; }
}
__device__ __forceinline__ void attn_prompt_unit(Frame& F, int li, int b, int g, int qt, int mode) { UNIT_BEGIN(F);
    const bf16_t* PROJ = WSP(bf16_t, WS_PROJ); const bf16_t* KC = WSP(bf16_t, WS_KC); bf16_t* OUT = WSP(bf16_t, WS_YMIX);
    const bf16_t* KT = (const bf16_t*)(F.lds + A_KT); const bf16_t* VT = (const bf16_t*)(F.lds + A_VT); const unsigned* SM = (const unsigned*)(F.lds + A_SM);
    const int lane = F.lane, w = F.wave, r = lane & 31, hi = lane >> 5, t0 = 32 * qt, tl = 4 * w + (r >> 3), pos = t0 + tl, hd = g * 8 + (r & 7); const size_t tok = (size_t)b * SEQ + pos;
    bf16x8 qf[4];
#pragma unroll
    for (int ks = 0; ks < 4; ++ks) qf[ks] = *(const bf16x8*)(PROJ + tok * IN_ODD_PAD + hd * 64 + 16 * ks + 8 * hi);
    scale_q(qf);
    float gate[3];
#pragma unroll
    for (int q = 0; q < 3; ++q) gate[q] = sigmoidf_(bf2f(PROJ[tok * IN_ODD_PAD + 1792 + hd * 3 + q]));
    LDS_BARRIER();
    stage_kv_bf16(F, 128, [&](int key, const bf16_t*& kp, const bf16_t*& vp) { if (key < NCMP_P) { kp = KC + (((size_t)0 * (BATCH + DEC_BATCH) + b) * 128 + key) * 128 + g * 64; vp = KC + (((size_t)1 * (BATCH + DEC_BATCH) + b) * 128 + key) * 128 + g * 64; } else { kp = nullptr; vp = nullptr; } });
    LDS_BARRIER();
    f32x16 tot[2], o[2];
    attn_cmp(F, qf, pos, NCMP_P, tl, (t0 + 4 * w + 3 >= 31) ? ((t0 + 4 * w + 3 - 31) >> 4) : -1, o);
    tot[0] = o[0] * gate[0]; tot[1] = o[1] * gate[0];
    LDS_BARRIER();
    attn_topk(F, 32, t0, NCMP_P, NSLC_P);
    const unsigned long long selm = (unsigned long long)SM[tl * 2] | ((unsigned long long)SM[tl * 2 + 1] << 32), orm = (unsigned long long)SM[64] | ((unsigned long long)SM[65] << 32);
    const int skey = F.tid >> 3, sc8 = F.tid & 7, spc = vperm(skey);
#define TILE_LOAD(j, colk, colv) do { const size_t kt_ = (size_t)b * SEQ + 64 * (j) + skey; rk = *(const u32x4*)(PROJ + kt_ * IN_ODD_PAD + (colk) + g * 64 + 8 * sc8); rv = *(const u32x4*)(PROJ + kt_ * IN_ODD_PAD + (colv) + g * 64 + 8 * sc8); } while (0)
#define TILE_WRITE(bufi) do { bf16_t* kb_ = (bf16_t*)(F.lds + (bufi) * 18432); bf16_t* vt_ = kb_ + 64 * 72 + vtoff(8 * sc8, spc, 72, 7); *(u32x4*)(kb_ + skey * 72 + 8 * sc8) = rk; \
        vt_[0] = (bf16_t)(rv.x & 0xffffu); vt_[72] = (bf16_t)(rv.x >> 16); vt_[144] = (bf16_t)(rv.y & 0xffffu); vt_[216] = (bf16_t)(rv.y >> 16); \
        vt_[288] = (bf16_t)(rv.z & 0xffffu); vt_[360] = (bf16_t)(rv.z >> 16); vt_[432] = (bf16_t)(rv.w & 0xffffu); vt_[504] = (bf16_t)(rv.w >> 16); } while (0)
    u32x4 rk, rv;
    if (mode != 3 && mode != 5) { float m = MINIT, l = 0.f; o[0] = Z16; o[1] = Z16; const int jmax = (t0 + 31) >> 6; const unsigned long long act = orm & (jmax >= 63 ? ~0ull : ((1ull << (jmax + 1)) - 1ull));
        if (act) { int j = __builtin_ctzll(act); unsigned long long rem = act & (act - 1ull); int buf = 0;
            TILE_LOAD(j, 1280, 1408); TILE_WRITE(0); int jn = rem ? __builtin_ctzll(rem) : -1; rem &= rem - 1ull; if (jn >= 0) TILE_LOAD(jn, 1280, 1408);
            LDS_BARRIER();
            for (;;) { const bf16_t* KB = (const bf16_t*)(F.lds + buf * 18432); const bf16_t* VB = KB + 64 * 72; const bool sel = (selm >> j) & 1ull; const bool allsel = __ballot(!sel) == 0ull;
                int jnn = -1;
                if (jn >= 0) { TILE_WRITE(buf ^ 1); jnn = rem ? __builtin_ctzll(rem) : -1; rem &= rem - 1ull; if (jnn >= 0) TILE_LOAD(jnn, 1280, 1408); }
                attn_tile64(KB, VB, qf, m, l, o, lane, allsel && (64 * j + 31 <= t0 + 4 * w), allsel && (64 * j + 63 <= t0 + 4 * w), [&](int ks, int kr) { return sel && (64 * j + 32 * ks + kr <= pos); });
                if (jn < 0) break;
                j = jn; jn = jnn;
                LDS_BARRIER(); buf ^= 1; }
            LDS_BARRIER(); }
        l += __shfl_xor(l, 32); const float sc = l > 0.f ? gate[1] / l : 0.f; tot[0] = tot[0] + o[0] * sc; tot[1] = tot[1] + o[1] * sc; }
    if (mode != 3 && mode != 4) { float m = MINIT, l = 0.f; o[0] = Z16; o[1] = Z16; const int jlo = (t0 - (WINDOW - 1)) > 0 ? ((t0 - (WINDOW - 1)) >> 6) : 0, jmax = (t0 + 31) >> 6; int j = jlo, buf = 0;
        TILE_LOAD(j, 1536, 1664); TILE_WRITE(0); if (j < jmax) TILE_LOAD(j + 1, 1536, 1664);
        LDS_BARRIER();
        for (;;) { const bf16_t* KB = (const bf16_t*)(F.lds + buf * 18432); const bf16_t* VB = KB + 64 * 72;
            if (j < jmax) { TILE_WRITE(buf ^ 1); if (j + 1 < jmax) TILE_LOAD(j + 2, 1536, 1664); }
            attn_tile64(KB, VB, qf, m, l, o, lane, (64 * j + 31 <= t0 + 4 * w) && (t0 + 4 * w + 3 - 64 * j < WINDOW), (64 * j + 63 <= t0 + 4 * w) && (t0 + 4 * w + 3 - (64 * j + 32) < WINDOW), [&](int ks, int kr) { const int rel = pos - (64 * j + 32 * ks + kr); return rel >= 0 && rel < WINDOW; });
            if (j >= jmax) break;
            ++j;
            LDS_BARRIER(); buf ^= 1; }
        LDS_BARRIER();
        l += __shfl_xor(l, 32); const float sc = l > 0.f ? gate[2] / l : 0.f; tot[0] = tot[0] + o[0] * sc; tot[1] = tot[1] + o[1] * sc; }
#undef TILE_LOAD
#undef TILE_WRITE
    if (mode < 3) store_o(OUT + tok * DM + hd * 64, tot, hi);
}
struct PrivRegs { f32x4 k[8], v[8]; };
template <class RowF> __device__ __forceinline__ void priv_load(PrivRegs& R, int lane, RowF rowfn) {
    const int key = lane >> 1, half = lane & 1; const float* kf; const float* vf; const bf16_t* kb; const bf16_t* vb; rowfn(key, kf, vf, kb, vb);
#pragma unroll
    for (int q = 0; q < 8; ++q) { R.k[q] = (f32x4){0.f, 0.f, 0.f, 0.f}; R.v[q] = (f32x4){0.f, 0.f, 0.f, 0.f}; }
    if (kf) {
#pragma unroll
        for (int q = 0; q < 8; ++q) { R.k[q] = ((const f32x4*)(kf + 32 * half))[q]; R.v[q] = ((const f32x4*)(vf + 32 * half))[q]; } }
    else if (kb) {
#pragma unroll
        for (int q = 0; q < 4; ++q) { const u32x4 ka = ((const u32x4*)(kb + 32 * half))[q], va = ((const u32x4*)(vb + 32 * half))[q];
            R.k[2 * q] = (f32x4){bflo(ka.x), bfhi(ka.x), bflo(ka.y), bfhi(ka.y)}; R.k[2 * q + 1] = (f32x4){bflo(ka.z), bfhi(ka.z), bflo(ka.w), bfhi(ka.w)};
            R.v[2 * q] = (f32x4){bflo(va.x), bfhi(va.x), bflo(va.y), bfhi(va.y)}; R.v[2 * q + 1] = (f32x4){bflo(va.z), bfhi(va.z), bflo(va.w), bfhi(va.w)}; } }
}
__device__ __forceinline__ void priv_write(const PrivRegs& R, bf16_t* PK, bf16_t* PV, int lane) {
    const int key = lane >> 1, half = lane & 1, pc = vperm(key);
#pragma unroll
    for (int q = 0; q < 4; ++q) { const f32x4 a = R.k[2 * q], a2 = R.k[2 * q + 1], c = R.v[2 * q], c2 = R.v[2 * q + 1];
        u32x4 w; w.x = pk2(a.x, a.y); w.y = pk2(a.z, a.w); w.z = pk2(a2.x, a2.y); w.w = pk2(a2.z, a2.w); *(u32x4*)(PK + key * PKP + 32 * half + 8 * q) = w;
        bf16_t* pv = PV + vtoff(32 * half + 8 * q, pc, PVP, 3); const unsigned c01 = pk2(c.x, c.y), c23 = pk2(c.z, c.w), c45 = pk2(c2.x, c2.y), c67 = pk2(c2.z, c2.w);
        pv[0] = (bf16_t)(c01 & 0xffffu); pv[PVP] = (bf16_t)(c01 >> 16); pv[2 * PVP] = (bf16_t)(c23 & 0xffffu); pv[3 * PVP] = (bf16_t)(c23 >> 16);
        pv[4 * PVP] = (bf16_t)(c45 & 0xffffu); pv[5 * PVP] = (bf16_t)(c45 >> 16); pv[6 * PVP] = (bf16_t)(c67 & 0xffffu); pv[7 * PVP] = (bf16_t)(c67 >> 16); }
}
__device__ __forceinline__ void merge_branch(Frame& F, float m, float l, const f32x16 (&o)[2], int gate_idx) {
    float* MB = (float*)(F.lds + A_PRIV); float* TOT = (float*)(F.lds + A_TOT); const float* GT = (const float*)(F.lds + A_GT);
    const int lane = F.lane, w = F.wave, r = lane & 31, hi = lane >> 5;
    LDS_BARRIER();
    { float* mb = MB + (w * 32 + r) * 66;
#pragma unroll
        for (int dt = 0; dt < 2; ++dt)
#pragma unroll
            for (int i = 0; i < 16; ++i) mb[32 * dt + crow(i, hi)] = o[dt][i];
        const float lt = l + __shfl_xor(l, 32); if (hi == 0) { mb[64] = m; mb[65] = lt; } }
    LDS_BARRIER();
    for (int e = F.tid; e < 32 * 64; e += NT) { const int q = e >> 6, d = e & 63; float M = NEGB;
#pragma unroll
        for (int ww = 0; ww < 8; ++ww) M = fmaxf(M, MB[(ww * 32 + q) * 66 + 64]);
        float L = 0.f, O = 0.f;
#pragma unroll
        for (int ww = 0; ww < 8; ++ww) { const float* mb = MB + (ww * 32 + q) * 66; const float sc = EXP2F(mb[64] - M); L += mb[65] * sc; O += mb[d] * sc; }
        if (L > 0.f) TOT[q * 64 + d] += GT[q * 4 + gate_idx] * O / L; }
    LDS_BARRIER();
}
__device__ __forceinline__ void attn_sample_unit(Frame& F, int li, int b, int g) { UNIT_BEGIN(F);
    const bf16_t* PROJ = WSP(bf16_t, WS_PROJ); const bf16_t* KC = WSP(bf16_t, WS_KC); bf16_t* OUT = WSP(bf16_t, WS_YMIX);
    const unsigned* SM = (const unsigned*)(F.lds + A_SM); float* TOT = (float*)(F.lds + A_TOT); float* GT = (float*)(F.lds + A_GT);
    const int lane = F.lane, w = F.wave, r = lane & 31, hi = lane >> 5, tl = r >> 3, pos = PAST + tl, hd = g * 8 + (r & 7); const size_t tok = (size_t)MP + b * DEC_SEQ + tl;
    bf16x8 qf[4];
#pragma unroll
    for (int ks = 0; ks < 4; ++ks) qf[ks] = *(const bf16x8*)(PROJ + tok * IN_ODD_PAD + hd * 64 + 16 * ks + 8 * hi);
    scale_q(qf);
    LDS_BARRIER();
    if (w == 0 && hi == 0) {
#pragma unroll
        for (int q = 0; q < 3; ++q) GT[r * 4 + q] = sigmoidf_(bf2f(PROJ[tok * IN_ODD_PAD + 1792 + hd * 3 + q])); }
    stage_kv_bf16(F, 128, [&](int key, const bf16_t*& kp, const bf16_t*& vp) { if (key < NCMP_S) { kp = KC + (((size_t)0 * (BATCH + DEC_BATCH) + BATCH + b) * 128 + key) * 128 + g * 64; vp = KC + (((size_t)1 * (BATCH + DEC_BATCH) + BATCH + b) * 128 + key) * 128 + g * 64; } else { kp = nullptr; vp = nullptr; } });
    LDS_BARRIER();
    f32x16 o[2];
    attn_cmp(F, qf, pos, NCMP_S, tl, NCMP_S - 1, o);
    if (w == 0) {
#pragma unroll
        for (int dt = 0; dt < 2; ++dt)
#pragma unroll
            for (int i = 0; i < 16; ++i) TOT[r * 64 + 32 * dt + crow(i, hi)] = o[dt][i] * GT[r * 4 + 0]; }
    LDS_BARRIER();
    attn_topk(F, DEC_SEQ, PAST, NCMP_S, NSLC_S);
    const unsigned long long selm = (unsigned long long)SM[tl * 2] | ((unsigned long long)SM[tl * 2 + 1] << 32), orm = (unsigned long long)SM[64] | ((unsigned long long)SM[65] << 32);
    bf16_t* PK = (bf16_t*)(F.lds + A_PRIV + w * PRIV_BYTES); bf16_t* PV = PK + 32 * PKP;
    const int* PT = (const int*)F.in[I_PT] + b * NPAGES;
    PrivRegs R;
    { float m = MINIT, l = 0.f; o[0] = Z16; o[1] = Z16;
        auto selrow = [&](int k0) { return [&, k0](int key, const float*& kf, const float*& vf, const bf16_t*& kb, const bf16_t*& vb) { const int row = k0 + key; kf = nullptr; vf = nullptr; kb = nullptr; vb = nullptr;
                if (row < PAST) { const float* base = F.in[I_CSEL] + (((size_t)li * NPOOL + PT[row >> 7]) * PAGE + (row & 127)) * 256 + g * 64; kf = base; vf = base + 128; }
                else if (row < PAST + DEC_SEQ) { const bf16_t* base = PROJ + ((size_t)MP + b * DEC_SEQ + (row - PAST)) * IN_ODD_PAD + 1280 + g * 64; kb = base; vb = base + 128; } }; };
        int sidx = w; while (sidx < 2 * NSLC_S && !((orm >> (sidx >> 1)) & 1ull)) sidx += 8;
        if (sidx < 2 * NSLC_S) { priv_load(R, lane, selrow(32 * sidx)); priv_write(R, PK, PV, lane); WAVE_SYNC(); }
        while (sidx < 2 * NSLC_S) { int nx = sidx + 8; while (nx < 2 * NSLC_S && !((orm >> (nx >> 1)) & 1ull)) nx += 8;
            if (nx < 2 * NSLC_S) priv_load(R, lane, selrow(32 * nx));
            const int j = sidx >> 1, k0 = 32 * sidx; const bool sel = (selm >> j) & 1ull;
            attn_sub32(PK, PKP, PV, PVP, 0, 3, qf, m, l, o, lane, false, [&](int kr) { return sel && (k0 + kr <= pos); });
            WAVE_SYNC();
            if (nx < 2 * NSLC_S) { priv_write(R, PK, PV, lane); WAVE_SYNC(); }
            sidx = nx; }
        merge_branch(F, m, l, o, 1); }
    { float m = MINIT, l = 0.f; o[0] = Z16; o[1] = Z16; constexpr int NSUBW = (WBUF + DEC_SEQ + 31) / 32;
        auto winrow = [&](int k0) { return [&, k0](int key, const float*& kf, const float*& vf, const bf16_t*& kb, const bf16_t*& vb) { const int row = k0 + key; kf = nullptr; vf = nullptr; kb = nullptr; vb = nullptr;
                if (row < WBUF) { const float* base = F.in[I_WINST] + (((size_t)li * DEC_BATCH + b) * WBUF + row) * 256 + g * 64; kf = base; vf = base + 128; }
                else if (row < WBUF + DEC_SEQ) { const bf16_t* base = PROJ + ((size_t)MP + b * DEC_SEQ + (row - WBUF)) * IN_ODD_PAD + 1536 + g * 64; kb = base; vb = base + 128; } }; };
        int sidx = w;
        if (sidx < NSUBW) { priv_load(R, lane, winrow(32 * sidx)); priv_write(R, PK, PV, lane); WAVE_SYNC(); }
        while (sidx < NSUBW) { const int nx = sidx + 8;
            if (nx < NSUBW) priv_load(R, lane, winrow(32 * nx));
            const int k0 = 32 * sidx;
            attn_sub32(PK, PKP, PV, PVP, 0, 3, qf, m, l, o, lane, false, [&](int kr) { const int rel = (WBUF + tl) - (k0 + kr); return rel >= 0 && rel < WINDOW && (k0 + kr) < WBUF + DEC_SEQ; });
            WAVE_SYNC();
            if (nx < NSUBW) { priv_write(R, PK, PV, lane); WAVE_SYNC(); }
            sidx = nx; }
        merge_branch(F, m, l, o, 2); }
    for (int e = F.tid; e < 32 * 64; e += NT) { const int q = e >> 6, d = e & 63; OUT[((size_t)MP + b * DEC_SEQ + (q >> 3)) * DM + (g * 8 + (q & 7)) * 64 + d] = (bf16_t)f2bf(TOT[e]); }
}
__device__ NOINLINE void ph_attn(Frame F, int li, int only) { frame_refresh(F);
    constexpr int NP = BATCH * 2 * (SEQ / 32), NS = DEC_BATCH * 2;
    if (only != 2) for (int u = F.bid; u < NP; u += F.G) { constexpr int NQ = SEQ / 32, QR = NQ / 4; const int idx = u / (BATCH * 2), bg = u % (BATCH * 2), rr = idx / QR, k = idx % QR;
        const int qt = (NQ % 4 == 0 && NP == 4 * F.G) ? (rr == 0 ? NQ - 1 - k : rr == 1 ? NQ / 2 + k : rr == 2 ? NQ / 2 - 1 - k : k) : (NQ - 1) - idx;
        attn_prompt_unit(F, li, bg >> 1, bg & 1, qt, only); }
    frame_refresh(F);
    if (only == 0 || only == 2) for (int v = F.bid; v < NS; v += F.G) attn_sample_unit(F, li, v >> 1, v & 1);
}
#ifndef CPU_EMU
#define XB_TMO      128
#define XB_XCNT(j)  (256  + 64 * (j))
#define XB_XSUB(j)  (1280 + 64 * (j))
#define XB_XGEN(j)  (2304 + 64 * (j))
#define XB_TOP      3328
#define XB_TOPGEN   3392
#define XCD_BAR_WORDS 3456
#define XB_SPIN_CAP (1u << 22)
__device__ __forceinline__ unsigned xb_ld(unsigned* p)              { return __hip_atomic_load(p, __ATOMIC_RELAXED, __HIP_MEMORY_SCOPE_AGENT); }
__device__ __forceinline__ unsigned xb_add(unsigned* p, unsigned v) { return __hip_atomic_fetch_add(p, v, __ATOMIC_RELAXED, __HIP_MEMORY_SCOPE_AGENT); }
__device__ __forceinline__ unsigned xb_xcc_id() { return (unsigned)__builtin_amdgcn_s_getreg((3 << 11) | 20) & 0xFu; }
#define XB_SPIN(cond, bar) do { unsigned _sp = 0; while (cond) { __builtin_amdgcn_s_sleep(1); \
    if ((++_sp & 255u) == 0u) { if (xb_ld(&(bar)[XB_TMO])) break; if (_sp > XB_SPIN_CAP) { atomicAdd(&(bar)[XB_TMO], 1u); break; } } } } while (0)
struct XcdBarrier { unsigned* bar; unsigned x; volatile LAS unsigned* st; };
__device__ __forceinline__ XcdBarrier xcd_barrier_post(unsigned* bar, volatile LAS unsigned* st) {
    XcdBarrier b; b.bar = bar; b.x = xb_xcc_id(); b.st = st;
    if (threadIdx.x == 0) (void)xb_add(&bar[XB_XCNT(b.x)], 1u);
    return b;
}
__device__ __forceinline__ void xcd_barrier_complete(unsigned* bar, unsigned x, unsigned& nloc, unsigned& nx) {
    const unsigned G = gridDim.x * gridDim.y * gridDim.z;
    unsigned sum, cnt, mine, sp = 0u;
    for (;;) {
        sum = 0u; cnt = 0u; mine = 0u;
#pragma unroll
        for (unsigned j = 0; j < 16; ++j) { const unsigned c = xb_ld(&bar[XB_XCNT(j)]); sum += c; cnt += (c > 0u) ? 1u : 0u; mine = (j == x) ? c : mine; }
        if (sum == G) break;
        __builtin_amdgcn_s_sleep(1);
        if ((++sp & 255u) == 0u) { if (xb_ld(&bar[XB_TMO])) break; if (sp > XB_SPIN_CAP) { atomicAdd(&bar[XB_TMO], 1u); break; } }
    }
    nloc = mine > 0u ? mine : 1u; nx = cnt > 0u ? cnt : 1u;
}
__device__ __forceinline__ void xcd_barrier(const XcdBarrier& b) {
    asm volatile("s_waitcnt vmcnt(0)" ::: "memory");
    __syncthreads();
    if (threadIdx.x == 0) {
        unsigned* bar = b.bar;
        __builtin_amdgcn_s_waitcnt(0);
        unsigned nloc = b.st[0], nx = b.st[1];
        if (nloc == 0u) { xcd_barrier_complete(bar, b.x, nloc, nx); b.st[0] = nloc; b.st[1] = nx; }
        const unsigned old = xb_add(&bar[XB_XSUB(b.x)], 1u);
        const unsigned gen = old / nloc;
        if (old + 1u == (gen + 1u) * nloc) {
            __builtin_amdgcn_fence(__ATOMIC_RELEASE, "agent");
            asm volatile("s_waitcnt vmcnt(0)" ::: "memory");
            const unsigned og = xb_add(&bar[XB_TOP], 1u);
            const unsigned tg = og / nx;
            if (og + 1u == (tg + 1u) * nx) xb_add(&bar[XB_TOPGEN], 1u);
            else XB_SPIN(xb_ld(&bar[XB_TOPGEN]) == tg, bar);
            __builtin_amdgcn_fence(__ATOMIC_ACQUIRE, "agent");
            xb_add(&bar[XB_XGEN(b.x)], 1u);
            asm volatile("s_waitcnt vmcnt(0)" ::: "memory");
        } else {
            XB_SPIN(xb_ld(&bar[XB_XGEN(b.x)]) == gen, bar);
            __builtin_amdgcn_fence(__ATOMIC_ACQUIRE, "agent");
            asm volatile("s_waitcnt vmcnt(0)" ::: "memory");
        }
    }
    __syncthreads();
}
#endif
constexpr int PH_PER_LAYER = 12, PH_END = 1 + DEPTH * PH_PER_LAYER;
__host__ __device__ inline bool phase_used(int id) {
    if (id == 0) return true;
    const int l = (id - 1) / PH_PER_LAYER, k = (id - 1) % PH_PER_LAYER;
    if (l >= DEPTH) return false;
    if ((l % 2 == 0) ? (k == 5 || k > 8) : (k == 3 || k == 6 || k > 9)) return false;
    if ((l % 2 == 0) ? (k == 8) : (k == 9)) return l == DEPTH - 1;
    return true;
}
constexpr int LAST_PHASE = 1 + (DEPTH - 1) * PH_PER_LAYER + ((DEPTH - 1) % 2 == 0 ? 8 : 9);

__global__ void __launch_bounds__(NT, 2) fwd(Args args) {
#ifdef CPU_EMU
    unsigned char* lds = (unsigned char*)emu::W->lds;
#else
    extern __shared__ __attribute__((aligned(16))) unsigned char lds[];
#endif
    Frame F; F.lds = (unsigned char*)lds; F.tid = threadIdx.x; F.lane = F.tid & 63; F.wave = RFL(F.tid >> 6); F.G = gridDim.x; F.bid = blockIdx.x;
    F.gw = F.bid * NWAVE + F.wave; F.NGW = F.G * NWAVE; F.out = args.out; F.ws = args.ws; F.in = args.in;
    const int lo = args.ph_lo, hi = args.ph_hi; const bool dup = args.dup != 0; const int only = args.dup >> 1;
#ifndef CPU_EMU
    const bool one_launch = (hi - lo) > 1;
    if (F.tid < 64) ((unsigned*)(lds + LDS_MISC))[F.tid] = 0u;
    __syncthreads();
    XcdBarrier bar; bar.bar = (unsigned*)(args.ws + WS_CTL) + 4096; bar.x = 0; bar.st = nullptr;
    if (one_launch) bar = xcd_barrier_post((unsigned*)(args.ws + WS_CTL) + 4096, (volatile LAS unsigned*)(lds + LDS_MISC));
#define SEAM(id) do { if (one_launch && (id) != LAST_PHASE) xcd_barrier(bar); } while (0)
#else
#define SEAM(id) do { } while (0)
#endif
#define IN(id) (lo <= (id) && (id) < hi && phase_used(id))
#define XN WSP(bf16_t, WS_XN)
#define SSQ WSP(float, WS_SSQ)
#define XBW (dup ? (bf16_t*)nullptr : XN)
#define SSQW (dup ? (float*)nullptr : SSQ)
#define X (dup ? WSP(float, WS_DUMMY) : WSP(float, WS_X))
#define H WSP(bf16_t, WS_H)
#define PROJ WSP(bf16_t, WS_PROJ)
#define YMIX WSP(bf16_t, WS_YMIX)
    if (IN(0)) { ph_prologue(F, only); SEAM(0); }
#pragma unroll
    for (int l = 0; l < DEPTH; ++l) {
        const int pb = 1 + l * PH_PER_LAYER, li = l >> 1;
        int k0;
        if ((l & 1) == 0) {
            if (IN(pb + 0)) { if (only != 2) pg8::gemm_call(XN, WSP(bf16_t, WS_WINE) + (size_t)li * IN_EVEN_PAD * DM, MT, IN_EVEN_PAD, DM, pg8::EpiBf16<0>{PROJ, IN_EVEN_PAD, SSQ, nullptr}, (int)gridDim.x, (int)blockIdx.x);
                SEAM(pb + 0); }
            if (IN(pb + 1)) { ph_even_local(F, li, only); SEAM(pb + 1); }
            if (IN(pb + 2)) { ph_ssd_carry(F, li); SEAM(pb + 2); }
            if (IN(pb + 3)) { ph_ssd_fix(F, li); SEAM(pb + 3); }
            if (IN(pb + 4)) { if (only != 2) pg8::gemm_call(YMIX, WSP(bf16_t, WS_WOUTE) + (size_t)li * DM * MIXE, MP, DM, MIXE, pg8::EpiResid{X, DM, XBW, SSQW}, (int)gridDim.x, (int)blockIdx.x);
                if (only != 1) ph_gemm_small(F, 2, YMIX + (size_t)MP * MIXE, WSP(bf16_t, WS_WOUTE) + (size_t)li * DM * MIXE, DM, MIXE, X + (size_t)MP * DM, DM, dup ? (bf16_t*)nullptr : XN + (size_t)MP * DM, dup ? (float*)nullptr : SSQ + (size_t)MP * 32); SEAM(pb + 4); }
            k0 = 5;
        } else {
            if (IN(pb + 0)) { if (only != 2) pg8::gemm_call(XN, WSP(bf16_t, WS_WINO) + (size_t)li * IN_ODD_PAD * DM, MP, IN_ODD_PAD, DM, pg8::EpiBf16<0>{PROJ, IN_ODD_PAD, SSQ, nullptr}, (int)gridDim.x, (int)blockIdx.x);
                if (only != 1) ph_gemm_small(F, 0, XN + (size_t)MP * DM, WSP(bf16_t, WS_WINO) + (size_t)li * IN_ODD_PAD * DM, IN_ODD_PAD, DM, PROJ + (size_t)MP * IN_ODD_PAD, IN_ODD_PAD, nullptr, SSQ + (size_t)MP * 32); SEAM(pb + 0); }
            if (IN(pb + 1)) { ph_odd_rope(F, li, dup, only); SEAM(pb + 1); }
            if (IN(pb + 2)) { for (int kv = 0; kv < 2; ++kv) pg8::gemm_call(WSP(bf16_t, WS_CMPA) + (size_t)kv * CMPROWS_PAD * 1024, WSP(bf16_t, WS_CW1) + (size_t)(li * 2 + kv) * 256 * 1024, CMPROWS_PAD, 256, 1024,
                    pg8::EpiCmp{WSP(bf16_t, WS_KC), WSP(bf16_t, WS_CW2T) + (size_t)(li * 2 + kv) * 64 * 128, WSP(float, WS_CBIAS) + (size_t)(li * 2 + kv) * 32 * 128, kv}, (int)gridDim.x, (int)blockIdx.x);
                if ((int)blockIdx.x >= CMPROWS_PAD / 256) ph_win_copy(F, li, (int)blockIdx.x - CMPROWS_PAD / 256, (int)gridDim.x - CMPROWS_PAD / 256);
                else if ((int)gridDim.x <= CMPROWS_PAD / 256) ph_win_copy(F, li, (int)blockIdx.x, (int)gridDim.x);
                SEAM(pb + 2); }
            if (IN(pb + 4)) { ph_attn(F, li, only); SEAM(pb + 4); }
            if (IN(pb + 5)) { if (only != 2) pg8::gemm_call(YMIX, WSP(bf16_t, WS_WOUTO) + (size_t)li * DM * DM, MP, DM, DM, pg8::EpiResid{X, DM, XBW, SSQW}, (int)gridDim.x, (int)blockIdx.x);
                if (only != 1) ph_gemm_small(F, 2, YMIX + (size_t)MP * DM, WSP(bf16_t, WS_WOUTO) + (size_t)li * DM * DM, DM, DM, X + (size_t)MP * DM, DM, dup ? (bf16_t*)nullptr : XN + (size_t)MP * DM, dup ? (float*)nullptr : SSQ + (size_t)MP * 32); SEAM(pb + 5); }
            k0 = 6;
        }
        if (IN(pb + k0 + 1)) { if (only != 2) pg8::gemm_call(XN, WSP(bf16_t, WS_WUP) + (size_t)l * DFF * DM, MP, DFF, DM, pg8::EpiBf16<1>{H, DFF, SSQ, nullptr}, (int)gridDim.x, (int)blockIdx.x);
            if (only != 1) ph_gemm_small(F, 1, XN + (size_t)MP * DM, WSP(bf16_t, WS_WUP) + (size_t)l * DFF * DM, DFF, DM, H + (size_t)MP * DFF, DFF, nullptr, SSQ + (size_t)MP * 32); SEAM(pb + k0 + 1); }
        if (IN(pb + k0 + 2)) { if (only != 2) pg8::gemm_call(H, WSP(bf16_t, WS_WDN) + (size_t)l * DM * DFF, MP, DM, DFF, pg8::EpiResid{X, DM, XBW, SSQW}, (int)gridDim.x, (int)blockIdx.x);
            if (only != 1) ph_gemm_small(F, 2, H + (size_t)MP * DFF, WSP(bf16_t, WS_WDN) + (size_t)l * DM * DFF, DM, DFF, X + (size_t)MP * DM, DM, dup ? (bf16_t*)nullptr : XN + (size_t)MP * DM, dup ? (float*)nullptr : SSQ + (size_t)MP * 32); SEAM(pb + k0 + 2); }
        if (IN(pb + k0 + 3)) { ph_norm(F, F.in[I_NFIN], true); SEAM(pb + k0 + 3); }
    }
}

#undef XN
#undef SSQ
#undef XBW
#undef SSQW
#undef X
#undef H
#undef PROJ
#undef YMIX
#ifndef PROBE_REP_MASK
#define PROBE_REP_MASK 0
#define PROBE_REP_N 1
#endif
#ifndef PROBE_SUB
#define PROBE_SUB 0
#endif
static int phase_class(int id) { if (id == 0) return 0; const int l = (id - 1) / PH_PER_LAYER, k = (id - 1) % PH_PER_LAYER;
    if ((l & 1) == 0) { const int m[9] = {1, 2, 3, 4, 5, 6, 7, 8, 6}; return m[k]; } else { const int m[10] = {1, 9, 10, 11, 12, 5, 6, 7, 8, 6}; return m[k]; } }
#ifndef ONE_LAUNCH
#define ONE_LAUNCH 0
#endif
extern "C" void kernel_launch(void* const* d_in, const int* in_sizes, int n_in, void* d_out, int out_size, void* d_ws, size_t ws_size, hipStream_t stream) {
    static int grid = 0;
    if (grid == 0) {
        if (n_in != N_IN || (size_t)out_size != O_END || ws_size < WS_END) { fprintf(stderr, "kernel_launch: shape mismatch n_in %d out %d (want %zu) ws %zu (want %zu)\n", n_in, out_size, (size_t)O_END, ws_size, (size_t)WS_END); grid = -1; return; }
#ifdef CPU_EMU
        grid = 32;
#else
        int dev = 0, cus = 0, per_cu = 0;
        if (hipGetDevice(&dev) != hipSuccess || hipDeviceGetAttribute(&cus, hipDeviceAttributeMultiprocessorCount, dev) != hipSuccess) { grid = -1; return; }
        if (hipFuncSetAttribute((const void*)fwd, hipFuncAttributeMaxDynamicSharedMemorySize, LDS_BYTES) != hipSuccess) { fprintf(stderr, "kernel_launch: hipFuncSetAttribute failed\n"); grid = -1; return; }
        if (hipOccupancyMaxActiveBlocksPerMultiprocessor(&per_cu, (const void*)fwd, NT, LDS_BYTES) != hipSuccess || per_cu < 1) fprintf(stderr, "kernel_launch: occupancy query says %d\n", per_cu);
        (void)hipGetLastError();
        if (cus < CMPROWS_PAD / 256) { fprintf(stderr, "kernel_launch: needs >= %d CUs\n", CMPROWS_PAD / 256); grid = -1; return; }
        grid = cus;
#endif
    }
    if (grid < 0) return;
    Args a{}; a.dup = 0; a.pad = 0;
    for (int i = 0; i < N_IN; ++i) a.in[i] = (const float*)d_in[i];
    a.out = (float*)d_out; a.ws = (unsigned char*)d_ws;
#ifdef CPU_EMU
    for (int id = 0; id < PH_END; ++id) if (phase_used(id)) { a.ph_lo = id; a.ph_hi = id + 1; emu::launch(dim3(grid), dim3(NT), LDS_BYTES, [=]() { fwd(a); }); emu_after_phase(id, a); }
#else
    (void)hipMemsetAsync((char*)d_ws + WS_CTL, 0, CTL_BYTES, stream);
    if (ONE_LAUNCH) { a.ph_lo = 0; a.ph_hi = PH_END; hipLaunchKernelGGL(fwd, dim3(grid), dim3(NT), LDS_BYTES, stream, a); }
    else for (int id = 0; id < PH_END; ++id) if (phase_used(id)) { a.ph_lo = id; a.ph_hi = id + 1; a.dup = 0; hipLaunchKernelGGL(fwd, dim3(grid), dim3(NT), LDS_BYTES, stream, a);
        if ((PROBE_REP_MASK >> phase_class(id)) & 1) for (int r = 0; r < PROBE_REP_N; ++r) { a.dup = 1 + 2 * PROBE_SUB; hipLaunchKernelGGL(fwd, dim3(grid), dim3(NT), LDS_BYTES, stream, a); } }
#endif
}
```
